# Optimizing an MI355X kernel written in HIP

```python
import jax, jax.numpy as jnp
from jax import lax
import numpy as np


D_MODEL = 1024
BATCH = 16
SEQ = 2048
DEPTH = 2

RET_HEADS = 4
RET_DK = 128
RET_DV = 256
RET_CHUNK = 128
GLA_HEADS = 4
GLA_DK = 128
GLA_DV = 256
GLA_RANK = 16
GLA_TAU = 16.0
GLA_LOG_GATE_MIN = -1.0
GLA_CHUNK = 64
SWA_Q_HEADS = 16
SWA_KV_HEADS = 4
SWA_HEAD_DIM = 64
SWA_WINDOW = 128
N_BRANCH = 3
BRANCH_WIDTH = RET_HEADS * RET_DV
D_FF = -(-8 * D_MODEL // (3 * 256)) * 256
NORM_EPS = 1e-6
GN_EPS = 1e-5

IN_SPLITS = (
    RET_HEADS * RET_DK, RET_HEADS * RET_DK, RET_HEADS * RET_DV, RET_HEADS * RET_DV,
    GLA_HEADS * GLA_DK, GLA_HEADS * GLA_DK, GLA_HEADS * GLA_DV, GLA_HEADS * GLA_DV, GLA_RANK,
    SWA_Q_HEADS * SWA_HEAD_DIM, SWA_KV_HEADS * SWA_HEAD_DIM, SWA_KV_HEADS * SWA_HEAD_DIM,
    N_BRANCH * D_MODEL,
)
D_IN = sum(IN_SPLITS)

kernel_name = "hybrid_retnet_gla_swa_gated_block"


def _split_points():
    return [int(o) for o in np.cumsum(IN_SPLITS)[:-1]]


def rmsnorm(x, w):
    xf = x.astype(jnp.float32)
    y = xf * lax.rsqrt(jnp.mean(xf * xf, axis=-1, keepdims=True) + NORM_EPS)
    return (y * w.astype(jnp.float32)).astype(x.dtype)


def head_groupnorm(o, w, b):
    B, S, H, dv = o.shape
    of = o.astype(jnp.float32)
    mu = jnp.mean(of, axis=-1, keepdims=True)
    var = jnp.mean(jnp.square(of - mu), axis=-1, keepdims=True)
    y = ((of - mu) * lax.rsqrt(var + GN_EPS)).reshape(B, S, H * dv)
    return y * w.astype(jnp.float32) + b.astype(jnp.float32)


def head_rmsnorm(o, w):
    B, S, H, dv = o.shape
    of = o.astype(jnp.float32)
    y = of * lax.rsqrt(jnp.mean(of * of, axis=-1, keepdims=True) + NORM_EPS)
    return y.reshape(B, S, H * dv) * w.astype(jnp.float32)


def retention(q, k, v):
    B, S, H, dk = q.shape
    dv = v.shape[-1]
    C = RET_CHUNK
    N = S // C
    log_g = jnp.log1p(-jnp.exp2(-5.0 - jnp.arange(H, dtype=jnp.float32)))
    q = (q * dk ** -0.5).reshape(B, N, C, H, dk)
    k = k.reshape(B, N, C, H, dk)
    v = v.reshape(B, N, C, H, dv)
    pos = jnp.arange(C, dtype=jnp.float32)
    rel = pos[:, None] - pos[None, :]
    decay = jnp.exp(jnp.where((rel >= 0)[None], rel[None] * log_g[:, None, None], -jnp.inf))
    scores = jnp.einsum('bnihd,bnjhd->bnhij', q, k) * decay
    intra = jnp.einsum('bnhij,bnjhe->bnihe', scores, v)
    zeta = jnp.exp((C - 1 - pos)[None, :] * log_g[:, None])
    kv = jnp.einsum('bnjhd,bnjhe,hj->nbhde', k, v, zeta)
    gamma_c = jnp.exp(C * log_g)[None, :, None, None]

    def step(R, kv_n):
        return gamma_c * R + kv_n, R

    _, states = lax.scan(step, jnp.zeros(kv.shape[1:], kv.dtype), kv)
    xi = jnp.exp((pos + 1.0)[:, None] * log_g[None, :])
    inter = jnp.einsum('bnihd,nbhde->bnihe', q * xi[:, :, None], states)
    return (intra + inter).reshape(B, S, H, dv)


def gla(q, k, v, log_a):
    B, S, H, dk = q.shape
    dv = v.shape[-1]
    C = GLA_CHUNK
    N = S // C
    q = (q * dk ** -0.5).reshape(B, N, C, H, dk)
    k = k.reshape(B, N, C, H, dk)
    v = v.reshape(B, N, C, H, dv)
    b = jnp.cumsum(log_a.reshape(B, N, C, H, dk), axis=2)
    b_last = b[:, :, -1:]
    q_dec = q * jnp.exp(b)
    k_inv = k * jnp.exp(-b)
    causal = jnp.tril(jnp.ones((C, C), dtype=bool))
    A = jnp.where(causal, jnp.einsum('bnihd,bnjhd->bnhij', q_dec, k_inv), 0.0)
    intra = jnp.einsum('bnhij,bnjhe->bnihe', A, v)
    kv = jnp.einsum('bnjhd,bnjhe->nbhde', k * jnp.exp(b_last - b), v)
    chunk_decay = jnp.moveaxis(jnp.exp(b_last[:, :, 0]), 1, 0)

    def step(St, inp):
        kv_n, a_n = inp
        return a_n[..., None] * St + kv_n, St

    _, states = lax.scan(step, jnp.zeros(kv.shape[1:], kv.dtype), (kv, chunk_decay))
    inter = jnp.einsum('bnihd,nbhde->bnihe', q_dec, states)
    return (intra + inter).reshape(B, S, H, dv)


def swa_sinks(q, k, v, sinks):
    B, S, Hq, dh = q.shape
    Hkv = k.shape[2]
    G = Hq // Hkv
    W = SWA_WINDOW
    N = S // W
    slopes = jnp.exp2(-8.0 * jnp.arange(1, Hq + 1, dtype=jnp.float32) / Hq).reshape(Hkv, G)
    qb = q.reshape(B, N, W, Hkv, G, dh)
    kb = k.reshape(B, N, W, Hkv, dh)
    vb = v.reshape(B, N, W, Hkv, dh)

    def with_prev(t):
        prev = jnp.pad(t[:, :-1], ((0, 0), (1, 0), (0, 0), (0, 0), (0, 0)))
        return jnp.concatenate([prev, t], axis=2)

    kk, vv = with_prev(kb), with_prev(vb)
    scores = jnp.einsum('bnqhgd,bnkhd->bnhgqk', qb, kk).astype(jnp.float32) * dh ** -0.5
    qpos = W + jnp.arange(W)
    kpos = jnp.arange(2 * W)
    dist = qpos[:, None] - kpos[None, :]
    blk = jnp.arange(N)
    valid = ((dist >= 0) & (dist < W))[None] & ((blk[:, None, None] > 0) | (kpos[None, None, :] >= W))
    logits = scores - slopes[:, :, None, None] * dist.astype(jnp.float32)
    logits = jnp.where(valid[None, :, None, None], logits, -jnp.inf)
    sink = sinks.astype(jnp.float32).reshape(Hkv, G)[:, :, None, None]
    m = jnp.maximum(jnp.max(logits, axis=-1, keepdims=True), sink)
    p = jnp.exp(logits - m)
    probs = p / (jnp.sum(p, axis=-1, keepdims=True) + jnp.exp(sink - m))
    out = jnp.einsum('bnhgqk,bnkhd->bnqhgd', probs.astype(v.dtype), vv)
    return out.reshape(B, S, Hq * dh)


def setup_inputs(seed: int = 0) -> dict:
    key = jax.random.key(seed)
    ks = jax.random.split(key, 17)
    f32 = jnp.float32

    def nrm(k, shape, scale):
        return jax.random.normal(k, shape, f32) * scale

    def gain(k, n):
        return 1.0 + nrm(k, (DEPTH, n), 0.05)

    return {
        'x': nrm(ks[0], (BATCH, SEQ, D_MODEL), 1.0),
        'norm_mix_pre': gain(ks[1], D_MODEL),
        'norm_mix_post': gain(ks[2], D_MODEL),
        'w_in': nrm(ks[3], (DEPTH, D_MODEL, D_IN), D_MODEL ** -0.5),
        'ret_norm_w': gain(ks[4], RET_HEADS * RET_DV),
        'ret_norm_b': nrm(ks[5], (DEPTH, RET_HEADS * RET_DV), 0.02),
        'gla_w_alpha2': nrm(ks[6], (DEPTH, GLA_RANK, GLA_HEADS * GLA_DK), GLA_RANK ** -0.5),
        'gla_b_alpha': nrm(ks[7], (DEPTH, GLA_HEADS * GLA_DK), 0.1),
        'gla_norm_w': gain(ks[8], GLA_HEADS * GLA_DV),
        'attn_sinks': nrm(ks[9], (DEPTH, SWA_Q_HEADS), 0.5),
        'w_branch': nrm(ks[10], (DEPTH, N_BRANCH, BRANCH_WIDTH, D_MODEL), BRANCH_WIDTH ** -0.5),
        'w_out': nrm(ks[11], (DEPTH, D_MODEL, D_MODEL), D_MODEL ** -0.5),
        'norm_ffn_pre': gain(ks[12], D_MODEL),
        'norm_ffn_post': gain(ks[13], D_MODEL),
        'ffn_w_gate': nrm(ks[14], (DEPTH, D_MODEL, D_FF), D_MODEL ** -0.5),
        'ffn_w_up': nrm(ks[15], (DEPTH, D_MODEL, D_FF), D_MODEL ** -0.5),
        'ffn_w_down': nrm(ks[16], (DEPTH, D_FF, D_MODEL), D_FF ** -0.5),
    }


def reference(x, norm_mix_pre, norm_mix_post, w_in, ret_norm_w, ret_norm_b, gla_w_alpha2,
              gla_b_alpha, gla_norm_w, attn_sinks, w_branch, w_out, norm_ffn_pre, norm_ffn_post,
              ffn_w_gate, ffn_w_up, ffn_w_down):
    B, S, _ = x.shape
    split_points = _split_points()
    for l in range(DEPTH):
        h = rmsnorm(x, norm_mix_pre[l])
        proj = h @ w_in[l]
        (rq, rk, rv, rg, gq, gk, gv, gg, ga, sq, sk, sv, gate_logits) = jnp.split(proj, split_points, axis=-1)

        o_ret = retention(rq.reshape(B, S, RET_HEADS, RET_DK), rk.reshape(B, S, RET_HEADS, RET_DK),
                          rv.reshape(B, S, RET_HEADS, RET_DV))
        o_ret = (head_groupnorm(o_ret, ret_norm_w[l], ret_norm_b[l]) * jax.nn.silu(rg)).astype(x.dtype)

        z = (ga @ gla_w_alpha2[l] + gla_b_alpha[l]).astype(jnp.float32)
        log_a = jnp.maximum(jax.nn.log_sigmoid(z) / GLA_TAU, GLA_LOG_GATE_MIN)
        o_gla = gla(gq.reshape(B, S, GLA_HEADS, GLA_DK), gk.reshape(B, S, GLA_HEADS, GLA_DK),
                    gv.reshape(B, S, GLA_HEADS, GLA_DV), log_a.reshape(B, S, GLA_HEADS, GLA_DK))
        o_gla = (head_rmsnorm(o_gla, gla_norm_w[l]) * jax.nn.silu(gg)).astype(x.dtype)

        o_swa = swa_sinks(sq.reshape(B, S, SWA_Q_HEADS, SWA_HEAD_DIM),
                          sk.reshape(B, S, SWA_KV_HEADS, SWA_HEAD_DIM),
                          sv.reshape(B, S, SWA_KV_HEADS, SWA_HEAD_DIM), attn_sinks[l]).astype(x.dtype)

        branches = jnp.stack([o_ret, o_gla, o_swa], axis=2)
        projected = jnp.einsum('bsnc,ncd->bsnd', branches, w_branch[l])
        gates = jax.nn.sigmoid(gate_logits.reshape(B, S, N_BRANCH, D_MODEL))
        merged = jnp.sum(gates * projected, axis=2)
        x = x + rmsnorm(merged @ w_out[l], norm_mix_post[l])

        h = rmsnorm(x, norm_ffn_pre[l])
        f = (jax.nn.silu(h @ ffn_w_gate[l]) * (h @ ffn_w_up[l])) @ ffn_w_down[l]
        x = x + rmsnorm(f, norm_ffn_post[l])
    return x
```

```cpp
#include <hip/hip_runtime.h>
#include <cstdio>
#include <cstdint>

typedef unsigned short bf16;
typedef short bf16x8 __attribute__((ext_vector_type(8)));
typedef float f32x4 __attribute__((ext_vector_type(4)));
typedef float f32x16 __attribute__((ext_vector_type(16)));
typedef unsigned u32x4 __attribute__((ext_vector_type(4)));
typedef unsigned u32x2 __attribute__((ext_vector_type(2)));

constexpr int BATCH = 16, SEQ = 2048, D = 1024, M = BATCH * SEQ, DEPTH = 2;
constexpr int DIN_ORIG = 10768, NP = 10752, FF = 2816, NGU = 2 * FF;
constexpr int C_RQ = 0, C_RK = 512, C_RV = 1024, C_RG = 2048, C_GQ = 3072, C_GK = 3584, C_GV = 4096, C_GG = 5120, C_SQ = 6144, C_SK = 7168, C_SV = 7424, C_GATE = 7680;
constexpr int C_MERGED = 3072, C_Y = 0;
constexpr int GA_ORIG = 6144;
constexpr int NSPLIT = 2, MH = M / NSPLIT, BH = BATCH / NSPLIT;
constexpr float NORM_EPS = 1e-6f, GN_EPS = 1e-5f;

constexpr size_t MiB = 1u << 20;
constexpr size_t WS_CTL = 0;
constexpr size_t WS_WIN = 1 * MiB;
constexpr size_t WS_WB = WS_WIN + (size_t)DEPTH * NP * D * 2;
constexpr size_t WS_WO = WS_WB + (size_t)DEPTH * 3 * D * D * 2;
constexpr size_t WS_WGU = WS_WO + (size_t)DEPTH * D * D * 2;
constexpr size_t WS_WD = WS_WGU + (size_t)DEPTH * NGU * D * 2;
constexpr size_t WS_GA = WS_WD + (size_t)DEPTH * D * FF * 2;
constexpr size_t WS_H = WS_GA + (size_t)M * 16 * 4;
constexpr size_t WS_PROJ = WS_H + (size_t)M * D * 2;
constexpr size_t WS_U = WS_PROJ;
constexpr size_t WS_F = WS_U + (size_t)M * FF * 2;
constexpr size_t WS_END = WS_PROJ + (size_t)MH * NP * 2;
static_assert(WS_F + (size_t)M * D * 2 <= WS_END, "ffn overlay");
static_assert(WS_END <= 512 * MiB, "workspace");

__device__ __forceinline__ unsigned f2bf(float f) { unsigned u = __builtin_bit_cast(unsigned, f); return (u + 0x7fffu + ((u >> 16) & 1u)) >> 16; }
__device__ __forceinline__ unsigned pk2(float lo, float hi) { return f2bf(lo) | (f2bf(hi) << 16); }
__device__ __forceinline__ float bf2f(unsigned short b) { return __builtin_bit_cast(float, ((unsigned)b) << 16); }
__device__ __forceinline__ float bflo(unsigned w) { return __builtin_bit_cast(float, w << 16); }
__device__ __forceinline__ float bfhi(unsigned w) { return __builtin_bit_cast(float, w & 0xffff0000u); }
__device__ __forceinline__ float wave_sum(float v) {
#pragma unroll
    for (int o = 1; o < 64; o <<= 1) v += __shfl_xor(v, o);
    return v;
}
__device__ __forceinline__ float wave_max(float v) {
#pragma unroll
    for (int o = 1; o < 64; o <<= 1) v = fmaxf(v, __shfl_xor(v, o));
    return v;
}
__device__ __forceinline__ float sigmoidf_(float x) { return 1.0f / (1.0f + __expf(-x)); }
__device__ __forceinline__ float siluf_(float x) { return x / (1.0f + __expf(-x)); }

__device__ __forceinline__ void transpose_item(const float* W, int ldw, int K, float scale, bf16* WT, float* scr, int k0, int lane) {
#pragma unroll 8
    for (int i = 0; i < 32; ++i) { const int kk = 2 * i + (lane >> 5); scr[kk * 33 + (lane & 31)] = W[(size_t)(k0 + kk) * ldw + (lane & 31)] * scale; }
    __builtin_amdgcn_s_waitcnt(0); __builtin_amdgcn_wave_barrier();
    const int c = lane & 7;
#pragma unroll
    for (int j = 0; j < 4; ++j) { const int n = (lane >> 3) + 8 * j; const float* s = scr + (8 * c) * 33 + n;
        u32x4 o; o.x = pk2(s[0 * 33], s[1 * 33]); o.y = pk2(s[2 * 33], s[3 * 33]); o.z = pk2(s[4 * 33], s[5 * 33]); o.w = pk2(s[6 * 33], s[7 * 33]);
        *(u32x4*)(WT + (size_t)n * K + k0 + 8 * c) = o; }
    __builtin_amdgcn_s_waitcnt(0); __builtin_amdgcn_wave_barrier();
}
struct WPtrs { const float *w_in, *w_branch, *w_out, *w_gate, *w_up, *w_down; };
constexpr int IT_WIN = (NP / 32) * (D / 64), IT_WB = 3 * (D / 32) * (D / 64), IT_WO = (D / 32) * (D / 64), IT_WGU = (NGU / 32) * (D / 64), IT_WD = (D / 32) * (FF / 64);
constexpr int IT_LAYER = IT_WIN + IT_WB + IT_WO + IT_WGU + IT_WD, IT_ALL = DEPTH * IT_LAYER;
__device__ __forceinline__ void convert_item(const WPtrs& P, unsigned char* ws, int item, float* scr, int lane) {
    const int l = item / IT_LAYER; int r = item % IT_LAYER;
    if (r < IT_WIN) { const int nb = r / (D / 64), kb = r % (D / 64); const int n0 = nb * 32; const int src = n0 < 6144 ? n0 : n0 + 16;
        const float sc = (n0 < 512 || (n0 >= C_GQ && n0 < C_GQ + 512)) ? 0.08838834764831845f : ((n0 >= C_SQ && n0 < C_SQ + 1024) ? 0.125f : 1.0f);
        transpose_item(P.w_in + (size_t)l * D * DIN_ORIG + src, DIN_ORIG, D, sc, (bf16*)(ws + WS_WIN) + ((size_t)l * NP + n0) * D, scr, kb * 64, lane); return; }
    r -= IT_WIN;
    if (r < IT_WB) { const int n = r / ((D / 32) * (D / 64)); const int q = r % ((D / 32) * (D / 64)); const int nb = q / (D / 64), kb = q % (D / 64);
        transpose_item(P.w_branch + ((size_t)(l * 3 + n) * D) * D + nb * 32, D, D, 1.0f, (bf16*)(ws + WS_WB) + ((size_t)(l * 3 + n) * D + nb * 32) * D, scr, kb * 64, lane); return; }
    r -= IT_WB;
    if (r < IT_WO) { const int nb = r / (D / 64), kb = r % (D / 64);
        transpose_item(P.w_out + (size_t)l * D * D + nb * 32, D, D, 1.0f, (bf16*)(ws + WS_WO) + ((size_t)l * D + nb * 32) * D, scr, kb * 64, lane); return; }
    r -= IT_WO;
    if (r < IT_WGU) { const int nb = r / (D / 64), kb = r % (D / 64); const int n0 = nb * 32; const int j = n0 / 256, i = n0 % 256;
        const float* src = (i < 128) ? (P.w_gate + (size_t)l * D * FF + 128 * j + i) : (P.w_up + (size_t)l * D * FF + 128 * j + (i - 128));
        transpose_item(src, FF, D, 1.0f, (bf16*)(ws + WS_WGU) + ((size_t)l * NGU + n0) * D, scr, kb * 64, lane); return; }
    r -= IT_WGU;
    { const int nb = r / (FF / 64), kb = r % (FF / 64);
        transpose_item(P.w_down + (size_t)l * FF * D + nb * 32, D, FF, 1.0f, (bf16*)(ws + WS_WD) + ((size_t)l * D + nb * 32) * FF, scr, kb * 64, lane); }
}
__global__ __launch_bounds__(256) void k_convert(WPtrs P, unsigned char* ws) {
    __shared__ float scr[4][64 * 33];
    const int wave = threadIdx.x >> 6, lane = threadIdx.x & 63;
    for (int it = blockIdx.x * 4 + wave; it < IT_ALL; it += gridDim.x * 4) convert_item(P, ws, it, scr[wave], lane);
}

struct NormArgs { const float* xin; float* xout; const bf16* Y; const float* wpost; const float* wpre; bf16* Hout; float* GAout; int ldy; int pad; };
__device__ __forceinline__ void norm_row(const NormArgs& A, int row, int yrow, int lane, const float* w1s) {
    const f32x4* xr = (const f32x4*)(A.xin + (size_t)row * D) + lane;
    f32x4 v[4];
#pragma unroll
    for (int j = 0; j < 4; ++j) v[j] = xr[64 * j];
    if (A.Y) {
        const u32x2* yr = (const u32x2*)(A.Y + (size_t)yrow * A.ldy) + lane; f32x4 y[4]; float ss = 0.f;
#pragma unroll
        for (int j = 0; j < 4; ++j) { const u32x2 w = yr[64 * j]; y[j] = (f32x4){bflo(w.x), bfhi(w.x), bflo(w.y), bfhi(w.y)}; ss += (y[j].x * y[j].x + y[j].y * y[j].y) + (y[j].z * y[j].z + y[j].w * y[j].w); }
        const float r = 1.0f / sqrtf(wave_sum(ss) * (1.0f / D) + NORM_EPS);
#pragma unroll
        for (int j = 0; j < 4; ++j) { const f32x4 w = ((const f32x4*)A.wpost)[lane + 64 * j]; v[j] = v[j] + y[j] * r * w; }
    }
    if (A.xout) { f32x4* xo = (f32x4*)(A.xout + (size_t)row * D) + lane;
#pragma unroll
        for (int j = 0; j < 4; ++j) xo[64 * j] = v[j]; }
    if (A.Hout) {
        float ss = 0.f;
#pragma unroll
        for (int j = 0; j < 4; ++j) ss += (v[j].x * v[j].x + v[j].y * v[j].y) + (v[j].z * v[j].z + v[j].w * v[j].w);
        const float r = 1.0f / sqrtf(wave_sum(ss) * (1.0f / D) + NORM_EPS);
        u32x2* ho = (u32x2*)(A.Hout + (size_t)row * D) + lane;
#pragma unroll
        for (int j = 0; j < 4; ++j) { const f32x4 w = ((const f32x4*)A.wpre)[lane + 64 * j]; v[j] = v[j] * r * w; u32x2 o; o.x = pk2(v[j].x, v[j].y); o.y = pk2(v[j].z, v[j].w); ho[64 * j] = o; }
        if (A.GAout) {
            float mine = 0.f;
#pragma unroll
            for (int c = 0; c < 16; ++c) { float p = 0.f;
#pragma unroll
                for (int j = 0; j < 4; ++j) { const f32x4 w = ((const f32x4*)(w1s + c * D))[lane + 64 * j]; p += (v[j].x * w.x + v[j].y * w.y) + (v[j].z * w.z + v[j].w * w.w); }
                p = wave_sum(p); if (lane == c) mine = p; }
            if (lane < 16) A.GAout[(size_t)row * 16 + lane] = mine;
        }
    }
}
__global__ __launch_bounds__(256) void k_norm(NormArgs A, const float* W1  , int row0, int nrows, int yrow0) {
    __shared__ float w1s[16 * D];
    if (A.GAout) { for (int i = threadIdx.x; i < 16 * D; i += 256) { const int k = i >> 4, c = i & 15; w1s[c * D + k] = W1[(size_t)k * DIN_ORIG + c]; } }
    __syncthreads();
    const int wave = threadIdx.x >> 6, lane = threadIdx.x & 63;
    for (int r = blockIdx.x * 4 + wave; r < nrows; r += gridDim.x * 4) norm_row(A, row0 + r, yrow0 + r, lane, w1s);
}

template <class Epi, bool DUAL>
__global__ __launch_bounds__(256) void k_gemm_naive(const bf16* A, int lda, const bf16* Bt, int ldb, int K, Epi epi) {
    __shared__ __attribute__((aligned(16))) bf16 sA[64][40];
    __shared__ __attribute__((aligned(16))) bf16 sB[64][40];
    __shared__ __attribute__((aligned(16))) bf16 sB2[64][40];
    const int tid = threadIdx.x, w = tid >> 6, lane = tid & 63, wm = w >> 1, wn = w & 1;
    const int m0 = blockIdx.y * 64, c0 = blockIdx.x * 64;
    int brow = c0, brow2 = 0;
    if (DUAL) { const int j = c0 / 128, i0 = c0 % 128; brow = 256 * j + i0; brow2 = brow + 128; }
    f32x16 acc, acc2;
#pragma unroll
    for (int i = 0; i < 16; ++i) { acc[i] = 0.f; acc2[i] = 0.f; }
    const int lr = tid >> 2, ls = tid & 3;
    for (int k0 = 0; k0 < K; k0 += 32) {
        *(u32x4*)&sA[lr][ls * 8] = *(const u32x4*)(A + (size_t)(m0 + lr) * lda + k0 + ls * 8);
        *(u32x4*)&sB[lr][ls * 8] = *(const u32x4*)(Bt + (size_t)(brow + lr) * ldb + k0 + ls * 8);
        if (DUAL) *(u32x4*)&sB2[lr][ls * 8] = *(const u32x4*)(Bt + (size_t)(brow2 + lr) * ldb + k0 + ls * 8);
        __syncthreads();
#pragma unroll
        for (int s = 0; s < 2; ++s) {
            const bf16x8 a = *(const bf16x8*)&sA[wm * 32 + (lane & 31)][s * 16 + 8 * (lane >> 5)];
            const bf16x8 b = *(const bf16x8*)&sB[wn * 32 + (lane & 31)][s * 16 + 8 * (lane >> 5)];
            acc = __builtin_amdgcn_mfma_f32_32x32x16_bf16(a, b, acc, 0, 0, 0);
            if (DUAL) { const bf16x8 b2 = *(const bf16x8*)&sB2[wn * 32 + (lane & 31)][s * 16 + 8 * (lane >> 5)]; acc2 = __builtin_amdgcn_mfma_f32_32x32x16_bf16(a, b2, acc2, 0, 0, 0); }
        }
        __syncthreads();
    }
#pragma unroll
    for (int r = 0; r < 16; ++r) {
        const int row = m0 + wm * 32 + (r & 3) + 8 * (r >> 2) + 4 * (lane >> 5), col = c0 + wn * 32 + (lane & 31);
        epi(row, col, acc[r], acc2[r]);
    }
}
struct EpiInProjN { bf16* P; __device__ void operator()(int row, int col, float v, float) const { const int pn = col >> 8;
    if ((pn >= 8 && pn < 12) || (pn >= 20 && pn < 24)) v = siluf_(v); else if (pn >= 30) v = sigmoidf_(v);
    P[(size_t)row * NP + col] = (bf16)f2bf(v); } };
struct EpiMergeN { bf16* P; int n; int pad; __device__ void operator()(int row, int col, float v, float) const {
    const float g = bf2f(P[(size_t)row * NP + C_GATE + 1024 * n + col]); float o = v * g; if (n > 0) o += bf2f(P[(size_t)row * NP + C_MERGED + col]);
    P[(size_t)row * NP + C_MERGED + col] = (bf16)f2bf(o); } };
struct EpiPlainN { bf16* O; int ldo; int pad; __device__ void operator()(int row, int col, float v, float) const { O[(size_t)row * ldo + col] = (bf16)f2bf(v); } };
struct EpiSwigluN { bf16* U; __device__ void operator()(int row, int col, float g, float u) const { U[(size_t)row * FF + col] = (bf16)f2bf(siluf_(g) * u); } };

template <bool GLA>
__global__ __launch_bounds__(256) void k_mix_rec(bf16* P, const float* GA  , const float* W2  , const float* balpha  ) {
    __shared__ __attribute__((aligned(16))) float sq[2][128], sk[2][128], sa[2][128];
    const int bl = blockIdx.x >> 2, h = blockIdx.x & 3, e = threadIdx.x;
    const int cq = (GLA ? C_GQ : C_RQ) + h * 128, ck = (GLA ? C_GK : C_RK) + h * 128, cv = (GLA ? C_GV : C_RV) + h * 256;
    float S[128];
#pragma unroll
    for (int d = 0; d < 128; ++d) S[d] = 0.f;
    const float gam = 1.0f - exp2f(-5.0f - (float)h);
    float w2r[16]; float ba = 0.f;
    if (GLA && e < 128) {
#pragma unroll
        for (int r = 0; r < 16; ++r) w2r[r] = W2[r * 512 + h * 128 + e];
        ba = balpha[h * 128 + e];
    }
    for (int t = 0; t < SEQ; ++t) {
        const size_t row = (size_t)bl * SEQ + t; const int pb = t & 1;
        if (e < 128) {
            sq[pb][e] = bf2f(P[row * NP + cq + e]); sk[pb][e] = bf2f(P[row * NP + ck + e]);
            float a = gam;
            if (GLA) { float z = ba;
#pragma unroll
                for (int r = 0; r < 16; ++r) z += GA[row * 16 + r] * w2r[r];
                const float ls = fminf(z, 0.f) - log1pf(__expf(-fabsf(z)));
                a = __expf(fmaxf(ls * (1.0f / 16.0f), -1.0f)); }
            sa[pb][e] = a;
        }
        const float v = bf2f(P[row * NP + cv + e]);
        __syncthreads();
        float o = 0.f;
#pragma unroll
        for (int d4 = 0; d4 < 32; ++d4) {
            const f32x4 q4 = *(const f32x4*)&sq[pb][4 * d4], k4 = *(const f32x4*)&sk[pb][4 * d4], a4 = *(const f32x4*)&sa[pb][4 * d4];
            S[4 * d4 + 0] = a4.x * S[4 * d4 + 0] + k4.x * v; o += q4.x * S[4 * d4 + 0];
            S[4 * d4 + 1] = a4.y * S[4 * d4 + 1] + k4.y * v; o += q4.y * S[4 * d4 + 1];
            S[4 * d4 + 2] = a4.z * S[4 * d4 + 2] + k4.z * v; o += q4.z * S[4 * d4 + 2];
            S[4 * d4 + 3] = a4.w * S[4 * d4 + 3] + k4.w * v; o += q4.w * S[4 * d4 + 3];
        }
        P[row * NP + cv + e] = (bf16)f2bf(o);
    }
}
__global__ __launch_bounds__(256) void k_norm_gate(bf16* P, const float* rw, const float* rb, const float* gw) {
    const int wave = threadIdx.x >> 6, lane = threadIdx.x & 63;
    for (int it = blockIdx.x * 4 + wave; it < MH * 8; it += gridDim.x * 4) {
        const int row = it >> 3, which = (it >> 2) & 1, h = it & 3;
        const int cv = (which ? C_GV : C_RV) + h * 256, cg = (which ? C_GG : C_RG) + h * 256;
        u32x2* op = (u32x2*)(P + (size_t)row * NP + cv) + lane; const u32x2 ow = *op; const u32x2 gw2 = *((const u32x2*)(P + (size_t)row * NP + cg) + lane);
        f32x4 o = {bflo(ow.x), bfhi(ow.x), bflo(ow.y), bfhi(ow.y)}; const f32x4 g = {bflo(gw2.x), bfhi(gw2.x), bflo(gw2.y), bfhi(gw2.y)};
        f32x4 y;
        if (!which) { const float mu = wave_sum((o.x + o.y) + (o.z + o.w)) * (1.0f / 256.0f); o = o - mu; const float var = wave_sum((o.x * o.x + o.y * o.y) + (o.z * o.z + o.w * o.w)) * (1.0f / 256.0f);
            const float r = 1.0f / sqrtf(var + GN_EPS); const f32x4 w = ((const f32x4*)(rw + h * 256))[lane], b = ((const f32x4*)(rb + h * 256))[lane]; y = (o * r * w + b) * g; }
        else { const float ms = wave_sum((o.x * o.x + o.y * o.y) + (o.z * o.z + o.w * o.w)) * (1.0f / 256.0f); const float r = 1.0f / sqrtf(ms + NORM_EPS); const f32x4 w = ((const f32x4*)(gw + h * 256))[lane]; y = o * r * w * g; }
        u32x2 out; out.x = pk2(y.x, y.y); out.y = pk2(y.z, y.w); *op = out;
    }
}
__global__ __launch_bounds__(256) void k_swa_naive(bf16* P, const float* sinks) {
    __shared__ float sqv[4][64];
    const int wave = threadIdx.x >> 6, lane = threadIdx.x & 63;
    for (int it = blockIdx.x * 4 + wave; it < MH * 16; it += gridDim.x * 4) {
        const int row = it >> 4, h = it & 15, kvh = h >> 2, t = row % SEQ;
        const float slope = exp2f(-8.0f * (float)(h + 1) / 16.0f), sink = sinks[h];
        sqv[wave][lane] = bf2f(P[(size_t)row * NP + C_SQ + h * 64 + lane]);
        __builtin_amdgcn_s_waitcnt(0); __builtin_amdgcn_wave_barrier();
        float lg[2];
#pragma unroll
        for (int u = 0; u < 2; ++u) { const int dist = lane + 64 * u; float s = -__builtin_inff();
            if (dist <= t) { const bf16* kr = P + (size_t)(row - dist) * NP + C_SK + kvh * 64; s = 0.f;
                for (int d = 0; d < 64; ++d) s += sqv[wave][d] * bf2f(kr[d]);
                s -= slope * (float)dist; }
            lg[u] = s; }
        const float m = fmaxf(wave_max(fmaxf(lg[0], lg[1])), sink);
        const float p0 = __expf(lg[0] - m), p1 = __expf(lg[1] - m);
        const float den = wave_sum(p0 + p1) + __expf(sink - m);
        float o = 0.f;
        for (int dist = 0; dist < 128; ++dist) { const float p = __shfl(dist < 64 ? p0 : p1, dist & 63); if (dist <= t) o += p * bf2f(P[(size_t)(row - dist) * NP + C_SV + kvh * 64 + lane]); }
        __builtin_amdgcn_wave_barrier();
        P[(size_t)row * NP + C_SQ + h * 64 + lane] = (bf16)f2bf(o / den);
    }
}

extern "C" void kernel_launch(void* const* d_in, const int* in_sizes, int n_in, void* d_out, int out_size, void* d_ws, size_t ws_size, hipStream_t stream) {
    if (ws_size < WS_END || n_in != 17 || out_size != M * D) { fprintf(stderr, "kernel_launch: unexpected sizes (ws %zu, need %zu)\n", ws_size, (size_t)WS_END); return; }
    const float* x = (const float*)d_in[0]; const float* norm_mix_pre = (const float*)d_in[1]; const float* norm_mix_post = (const float*)d_in[2]; const float* w_in = (const float*)d_in[3];
    const float* ret_norm_w = (const float*)d_in[4]; const float* ret_norm_b = (const float*)d_in[5]; const float* gla_w_alpha2 = (const float*)d_in[6]; const float* gla_b_alpha = (const float*)d_in[7];
    const float* gla_norm_w = (const float*)d_in[8]; const float* attn_sinks = (const float*)d_in[9]; const float* w_branch = (const float*)d_in[10]; const float* w_out = (const float*)d_in[11];
    const float* norm_ffn_pre = (const float*)d_in[12]; const float* norm_ffn_post = (const float*)d_in[13]; const float* ffn_w_gate = (const float*)d_in[14]; const float* ffn_w_up = (const float*)d_in[15]; const float* ffn_w_down = (const float*)d_in[16];
    unsigned char* ws = (unsigned char*)d_ws; float* out = (float*)d_out;
    bf16* WinT = (bf16*)(ws + WS_WIN); bf16* WbT = (bf16*)(ws + WS_WB); bf16* WoT = (bf16*)(ws + WS_WO); bf16* WguT = (bf16*)(ws + WS_WGU); bf16* WdT = (bf16*)(ws + WS_WD);
    float* GA = (float*)(ws + WS_GA); bf16* H = (bf16*)(ws + WS_H); bf16* PROJ = (bf16*)(ws + WS_PROJ); bf16* U = (bf16*)(ws + WS_U); bf16* F = (bf16*)(ws + WS_F);
    WPtrs wp{w_in, w_branch, w_out, ffn_w_gate, ffn_w_up, ffn_w_down};
    k_convert<<<1024, 256, 0, stream>>>(wp, ws);
    { NormArgs a{x, nullptr, nullptr, nullptr, norm_mix_pre, H, GA, 0, 0}; k_norm<<<1024, 256, 0, stream>>>(a, w_in + GA_ORIG, 0, M, 0); }
    for (int l = 0; l < DEPTH; ++l) {
        const float* xin = l == 0 ? x : out;
        for (int hf = 0; hf < NSPLIT; ++hf) {
            const int r0 = hf * MH;
            { EpiInProjN e{PROJ}; k_gemm_naive<EpiInProjN, false><<<dim3(NP / 64, MH / 64), 256, 0, stream>>>(H + (size_t)r0 * D, D, WinT + (size_t)l * NP * D, D, D, e); }
            k_mix_rec<false><<<BH * 4, 256, 0, stream>>>(PROJ, nullptr, nullptr, nullptr);
            k_mix_rec<true><<<BH * 4, 256, 0, stream>>>(PROJ, GA + (size_t)r0 * 16, gla_w_alpha2 + (size_t)l * 16 * 512, gla_b_alpha + (size_t)l * 512);
            k_norm_gate<<<2048, 256, 0, stream>>>(PROJ, ret_norm_w + l * 1024, ret_norm_b + l * 1024, gla_norm_w + l * 1024);
            k_swa_naive<<<2048, 256, 0, stream>>>(PROJ, attn_sinks + l * 16);
            for (int n = 0; n < 3; ++n) { const int ca = n == 0 ? C_RV : (n == 1 ? C_GV : C_SQ); EpiMergeN e{PROJ, n, 0};
                k_gemm_naive<EpiMergeN, false><<<dim3(D / 64, MH / 64), 256, 0, stream>>>(PROJ + ca, NP, WbT + (size_t)(l * 3 + n) * D * D, D, D, e); }
            { EpiPlainN e{PROJ + C_Y, NP, 0}; k_gemm_naive<EpiPlainN, false><<<dim3(D / 64, MH / 64), 256, 0, stream>>>(PROJ + C_MERGED, NP, WoT + (size_t)l * D * D, D, D, e); }
            { NormArgs a{xin, out, PROJ + C_Y, norm_mix_post + l * D, norm_ffn_pre + l * D, H, nullptr, NP, 0}; k_norm<<<1024, 256, 0, stream>>>(a, nullptr, r0, MH, 0); }
        }
        { EpiSwigluN e{U}; k_gemm_naive<EpiSwigluN, true><<<dim3(FF / 64, M / 64), 256, 0, stream>>>(H, D, WguT + (size_t)l * NGU * D, D, D, e); }
        { EpiPlainN e{F, D, 0}; k_gemm_naive<EpiPlainN, false><<<dim3(D / 64, M / 64), 256, 0, stream>>>(U, FF, WdT + (size_t)l * D * FF, FF, FF, e); }
        if (l + 1 < DEPTH) { NormArgs a{out, out, F, norm_ffn_post + l * D, norm_mix_pre + (l + 1) * D, H, GA, D, 0}; k_norm<<<1024, 256, 0, stream>>>(a, w_in + (size_t)(l + 1) * D * DIN_ORIG + GA_ORIG, 0, M, 0); }
        else { NormArgs a{out, out, F, norm_ffn_post + l * D, nullptr, nullptr, nullptr, D, 0}; k_norm<<<1024, 256, 0, stream>>>(a, nullptr, 0, M, 0); }
    }
}
```

```cpp
#include <hip/hip_runtime.h>
#include <cstdio>
#include <cstdint>

typedef unsigned short bf16;
typedef short bf16x8 __attribute__((ext_vector_type(8)));
typedef short s16x4 __attribute__((ext_vector_type(4)));
typedef float f32x2 __attribute__((ext_vector_type(2)));
typedef float f32x4 __attribute__((ext_vector_type(4)));
typedef float f32x16 __attribute__((ext_vector_type(16)));
typedef unsigned u32x4 __attribute__((ext_vector_type(4)));
typedef unsigned u32x2 __attribute__((ext_vector_type(2)));
#define GAS __attribute__((address_space(1)))
#define LAS __attribute__((address_space(3)))
typedef GAS unsigned gu32;

constexpr int BATCH = 16, SEQ = 2048, D = 1024, M = BATCH * SEQ, DEPTH = 2;
constexpr int DIN_ORIG = 10768, NP = 10752, FF = 2816, NGU = 2 * FF;
constexpr int C_RQ = 0, C_RK = 512, C_RV = 1024, C_RG = 2048, C_GQ = 3072, C_GK = 3584, C_GV = 4096, C_GG = 5120, C_SQ = 6144, C_SK = 7168, C_SV = 7424, C_GATE = 7680;
constexpr int C_MERGED = 3072, C_Y = 0;
constexpr int GA_ORIG = 6144;
constexpr int NSPLIT = 2, MH = M / NSPLIT, BH = BATCH / NSPLIT;
constexpr int CH = 64, NCH = SEQ / CH;
constexpr float NORM_EPS = 1e-6f, GN_EPS = 1e-5f;

constexpr size_t MiB = 1u << 20;
constexpr size_t WS_CTL = 0, CTL_ZERO_BYTES = 256 * 1024;
constexpr size_t WS_EBL = 256 * 1024;
constexpr size_t WS_WIN = 1 * MiB;
constexpr size_t WS_WB = WS_WIN + (size_t)DEPTH * NP * D * 2;
constexpr size_t WS_WO = WS_WB + (size_t)DEPTH * 3 * D * D * 2;
constexpr size_t WS_WGU = WS_WO + (size_t)DEPTH * D * D * 2;
constexpr size_t WS_WD = WS_WGU + (size_t)DEPTH * NGU * D * 2;
constexpr size_t WS_GA = WS_WD + (size_t)DEPTH * D * FF * 2;
constexpr size_t WS_H = WS_GA + (size_t)M * 16 * 4;
constexpr size_t WS_PROJ = WS_H + (size_t)M * D * 2;
constexpr size_t WS_U = WS_PROJ;
constexpr size_t WS_F = WS_U + (size_t)M * FF * 2;
constexpr size_t WS_END = WS_PROJ + (size_t)MH * NP * 2;
static_assert(WS_EBL + (size_t)(MH / 64) * 512 * 4 <= WS_WIN, "ebl");
static_assert(WS_F + (size_t)M * D * 2 <= WS_END, "ffn overlay");
static_assert(WS_END <= 512 * MiB, "workspace");

__device__ __forceinline__ unsigned f2bf(float f) { unsigned u = __builtin_bit_cast(unsigned, f); return (u + 0x7fffu + ((u >> 16) & 1u)) >> 16; }
__device__ __forceinline__ unsigned pk2(float lo, float hi) { return f2bf(lo) | (f2bf(hi) << 16); }
typedef __bf16 bf16x2_t __attribute__((ext_vector_type(2)));
__device__ __forceinline__ unsigned cvtpk(float lo, float hi) { f32x2 v = {lo, hi}; bf16x2_t b = __builtin_convertvector(v, bf16x2_t); return __builtin_bit_cast(unsigned, b); }
__device__ __forceinline__ float bf2f(unsigned short b) { return __builtin_bit_cast(float, ((unsigned)b) << 16); }
__device__ __forceinline__ float bflo(unsigned w) { return __builtin_bit_cast(float, w << 16); }
__device__ __forceinline__ float bfhi(unsigned w) { return __builtin_bit_cast(float, w & 0xffff0000u); }
__device__ __forceinline__ float wave_sum(float v) {
#pragma unroll
    for (int o = 1; o < 64; o <<= 1) v += __shfl_xor(v, o);
    return v;
}
__device__ __forceinline__ float wave_max(float v) {
#pragma unroll
    for (int o = 1; o < 64; o <<= 1) v = fmaxf(v, __shfl_xor(v, o));
    return v;
}
__device__ __forceinline__ float sigmoidf_(float x) { return __builtin_amdgcn_rcpf(1.0f + __expf(-x)); }
__device__ __forceinline__ float siluf_(float x) { return x * __builtin_amdgcn_rcpf(1.0f + __expf(-x)); }
#define SINGLE_LAUNCH 1
namespace pg8 {
typedef unsigned short bf16_t;
constexpr int BM = 256, BK = 64, HALF = 128, HTB = HALF * BK * 2, STAGE_BYTES = 8 * HTB, NXCD = 8, WGM = 8;
__host__ __device__ __forceinline__ int lds_byte(int r, int c) { const int st = (r >> 4) * 2 + (c >> 5), rr = r & 15, cc = c & 31, ob = rr * 64 + cc * 2; return st * 1024 + (ob ^ (((ob >> 9) & 1) << 5)); }
__host__ __device__ __forceinline__ void stage_rc(int b, int& R, int& C) { const int st = b / 1024, sb = b % 1024, swz = sb ^ (((sb >> 9) & 1) << 5); R = (st >> 1) * 16 + swz / 64; C = (st & 1) * 32 + (swz % 64) / 2; }
__host__ __device__ __forceinline__ int perm32(int rho) { const int n = rho >> 4, i = rho & 15; return 8 * (i >> 2) + 4 * n + (i & 3); }

struct Unit { int pm, pn, aoff; };
struct Gemm { const bf16_t* A; const bf16_t* Bt; int lda, ldb, K; };

struct StaticOrder {
    int nM, nN, nwg, G, c;
    __host__ __device__ void init(int M_, int N_, int G_, int c_) { nM = M_ / BM; nN = N_ / BM; nwg = nM * nN; G = G_; c = c_; }
    __host__ __device__ bool next(int i, Unit& u) const {
        const long L = (long)i * G + c; if (L >= nwg) return false;
        int wgid = (int)L; { const int q = nwg / NXCD, r = nwg % NXCD, xcd = wgid % NXCD, off = wgid / NXCD; wgid = (xcd < r ? xcd * (q + 1) : r * (q + 1) + (xcd - r) * q) + off; }
        const int nig = WGM * nN, gid = wgid / nig, fm = gid * WGM, gsz = (nM - fm) < WGM ? (nM - fm) : WGM;
        u.pm = fm + ((wgid % nig) % gsz); u.pn = (wgid % nig) / gsz; u.aoff = 0; return true;
    }
};
struct MergeOrder {
    StaticOrder so;
    __host__ __device__ void init(int M_, int G_, int c_) { so.init(M_, D, G_, c_); }
    __host__ __device__ bool next(int i, Unit& u) const { Unit t; if (!so.next(i / 3, t)) return false; const int n = i % 3; u.pm = t.pm; u.pn = n * 4 + t.pn; u.aoff = (n == 0 ? C_RV : (n == 1 ? C_GV : C_SQ)) * 2; return true; }
};

__device__ __forceinline__ u32x4 pack8(const f32x4& v0, const f32x4& v1) { u32x4 w; w.x = cvtpk(v0[0], v0[1]); w.y = cvtpk(v0[2], v0[3]); w.z = cvtpk(v1[0], v1[1]); w.w = cvtpk(v1[2], v1[3]); return w; }
__device__ __forceinline__ void unpack8(const u32x4& w, f32x4& v0, f32x4& v1) { v0 = (f32x4){bflo(w.x), bfhi(w.x), bflo(w.y), bfhi(w.y)}; v1 = (f32x4){bflo(w.z), bfhi(w.z), bflo(w.w), bfhi(w.w)}; }
struct EpiInProj {
    static constexpr bool PERM = true;
    bf16_t* P; int ret_scale; int pad;
    __device__ __forceinline__ void operator()(const f32x4 (&acc)[2][2][4][2], const Unit& u, int wr, int wc, int fr, int fq) const {
        const int row0 = u.pm * BM + wr * 64 + fr, col0 = u.pn * BM + wc * 32 + 8 * fq, pn = u.pn;
        const int act = ((pn >= 8 && pn < 12) || (pn >= 20 && pn < 24)) ? 1 : (pn >= 30 ? 2 : 0);
        const bool rs = ret_scale && pn < 4;
#pragma unroll
        for (int ai = 0; ai < 2; ++ai)
#pragma unroll
            for (int m = 0; m < 4; ++m) { bf16_t* rowp = P + (size_t)(row0 + ai * HALF + m * 16) * NP + col0;
#pragma unroll
                for (int bj = 0; bj < 2; ++bj) { f32x4 v0 = acc[ai][bj][m][0], v1 = acc[ai][bj][m][1];
                    if (act == 1) {
#pragma unroll
                        for (int j = 0; j < 4; ++j) { v0[j] = siluf_(v0[j]); v1[j] = siluf_(v1[j]); } }
                    if (act == 2) {
#pragma unroll
                        for (int j = 0; j < 4; ++j) { v0[j] = sigmoidf_(v0[j]); v1[j] = sigmoidf_(v1[j]); } }
                    if (rs) { const int h = 2 * (pn & 1) + bj; const float lg = log2f(1.0f - exp2f(-5.0f - (float)h)); const float e = (float)(fr + 16 * m + 1) * lg;
                        const float s = exp2f(pn < 2 ? e : -e); v0 = v0 * s; v1 = v1 * s; }
                    *(u32x4*)(rowp + bj * HALF) = pack8(v0, v1); } }
    }
};
struct EpiMerge {
    static constexpr bool PERM = true;
    bf16_t* P;
    __device__ __forceinline__ void operator()(const f32x4 (&acc)[2][2][4][2], const Unit& u, int wr, int wc, int fr, int fq) const {
        const int n = u.pn >> 2, ct = u.pn & 3; const int row0 = u.pm * BM + wr * 64 + fr, col0 = ct * BM + wc * 32 + 8 * fq;
#pragma unroll
        for (int ai = 0; ai < 2; ++ai)
#pragma unroll
            for (int m = 0; m < 4; ++m) { bf16_t* rowp = P + (size_t)(row0 + ai * HALF + m * 16) * NP + col0;
#pragma unroll
                for (int bj = 0; bj < 2; ++bj) { f32x4 g0, g1; unpack8(*(const u32x4*)(rowp + C_GATE + 1024 * n + bj * HALF), g0, g1);
                    f32x4 v0 = acc[ai][bj][m][0] * g0, v1 = acc[ai][bj][m][1] * g1;
                    if (n > 0) { f32x4 p0, p1; unpack8(*(const u32x4*)(rowp + C_MERGED + bj * HALF), p0, p1); v0 = v0 + p0; v1 = v1 + p1; }
                    *(u32x4*)(rowp + C_MERGED + bj * HALF) = pack8(v0, v1); } }
    }
};
struct EpiPlain {
    static constexpr bool PERM = true;
    bf16_t* O; int ldo; int pad;
    __device__ __forceinline__ void operator()(const f32x4 (&acc)[2][2][4][2], const Unit& u, int wr, int wc, int fr, int fq) const {
        const int row0 = u.pm * BM + wr * 64 + fr, col0 = u.pn * BM + wc * 32 + 8 * fq;
#pragma unroll
        for (int ai = 0; ai < 2; ++ai)
#pragma unroll
            for (int m = 0; m < 4; ++m) { bf16_t* rowp = O + (size_t)(row0 + ai * HALF + m * 16) * ldo + col0;
#pragma unroll
                for (int bj = 0; bj < 2; ++bj) *(u32x4*)(rowp + bj * HALF) = pack8(acc[ai][bj][m][0], acc[ai][bj][m][1]); }
    }
};
struct EpiSwiglu {
    static constexpr bool PERM = true;
    bf16_t* U;
    __device__ __forceinline__ void operator()(const f32x4 (&acc)[2][2][4][2], const Unit& u, int wr, int wc, int fr, int fq) const {
        const int row0 = u.pm * BM + wr * 64 + fr, col0 = u.pn * HALF + wc * 32 + 8 * fq;
#pragma unroll
        for (int ai = 0; ai < 2; ++ai)
#pragma unroll
            for (int m = 0; m < 4; ++m) { f32x4 v0, v1;
#pragma unroll
                for (int j = 0; j < 4; ++j) { v0[j] = siluf_(acc[ai][0][m][0][j]) * acc[ai][1][m][0][j]; v1[j] = siluf_(acc[ai][0][m][1][j]) * acc[ai][1][m][1][j]; }
                *(u32x4*)(U + (size_t)(row0 + ai * HALF + m * 16) * FF + col0) = pack8(v0, v1); }
    }
};

template <class Epi, class Sched>
__device__ __forceinline__ void gemm_phase(LAS unsigned char* lds, const Gemm g, const Sched& S, const Epi& E) {
    int tid_ = threadIdx.x; asm volatile("" : "+v"(tid_));
    const int tid = tid_, wid = __builtin_amdgcn_readfirstlane(tid >> 6), lane = tid & 63, wr = wid >> 2, wc = wid & 3, fr = lane & 15, fq = lane >> 4;
    const int nt = g.K / BK;
    unsigned voffA[2], voffB[2];
#pragma unroll
    for (int i = 0; i < 2; ++i) { int R, C; stage_rc(tid * 16 + i * 8192, R, C); const int Rb = Epi::PERM ? ((R & ~31) + perm32(R & 31)) : R;
        voffA[i] = (unsigned)(R * g.lda + C) * 2u; voffB[i] = (unsigned)(Rb * g.ldb + C) * 2u; }
    const size_t kstep = (size_t)(BK * 2);
    const size_t hstepA = (size_t)HALF * g.lda * 2, hstepB = (size_t)HALF * g.ldb * 2;
    const size_t tstepA = 2 * hstepA, tstepB = 2 * hstepB;
    const unsigned ldsw = (unsigned)wid * 1024u;
    const int aoff = lds_byte(wr * 64 + fr, fq * 8), boff = lds_byte(wc * 32 + fr, fq * 8);
#define PG8_SA(b, h) (((b) * 2 + (h)) * HTB)
#define PG8_SB(b, h) ((4 + (b) * 2 + (h)) * HTB)
#define PG8_STAGE(bufoff, gbase, voff) do { _Pragma("unroll") for (int _i = 0; _i < 2; ++_i) \
        __builtin_amdgcn_global_load_lds((const unsigned*)((const char*)(gbase) + (voff)[_i]), (LAS unsigned*)(lds + (bufoff) + ldsw + _i * 8192), 16, 0, 0); } while (0)
#define PG8_LDA(dst, b, h) do { _Pragma("unroll") for (int m = 0; m < 4; ++m) _Pragma("unroll") for (int k = 0; k < 2; ++k) dst[m][k] = *(const LAS bf16x8*)(lds + PG8_SA(b, h) + aoff + m * 2048 + k * 1024); } while (0)
#define PG8_LDB(dst, b, h) do { _Pragma("unroll") for (int n = 0; n < 2; ++n) _Pragma("unroll") for (int k = 0; k < 2; ++k) dst[n][k] = *(const LAS bf16x8*)(lds + PG8_SB(b, h) + boff + n * 2048 + k * 1024); } while (0)
#define PG8_MMA(ai, bj, At, Bt) do { __builtin_amdgcn_s_setprio(1); _Pragma("unroll") for (int m = 0; m < 4; ++m) _Pragma("unroll") for (int n = 0; n < 2; ++n) _Pragma("unroll") for (int k = 0; k < 2; ++k) \
        acc[ai][bj][m][n] = __builtin_amdgcn_mfma_f32_16x16x32_bf16(Bt[n][k], At[m][k], acc[ai][bj][m][n], 0, 0, 0); __builtin_amdgcn_s_setprio(0); } while (0)
#define PG8_WAIT_V(n) asm volatile("s_waitcnt vmcnt(" #n ")" ::: "memory")
#define PG8_WAIT_L(n) asm volatile("s_waitcnt lgkmcnt(" #n ")" ::: "memory")
#define PG8_BAR __builtin_amdgcn_s_barrier()
#define PG8_SCHED __builtin_amdgcn_sched_barrier(0)
    Unit cur, nxt; int ui = 0;
    if (!S.next(0, cur)) return;
    f32x4 acc[2][2][4][2];
#pragma unroll
    for (int a = 0; a < 2; ++a)
#pragma unroll
        for (int b = 0; b < 2; ++b)
#pragma unroll
            for (int m = 0; m < 4; ++m)
#pragma unroll
                for (int n = 0; n < 2; ++n) acc[a][b][m][n] = (f32x4){0.f, 0.f, 0.f, 0.f};
    bf16x8 At[4][2], B0[2][2], B1[2][2];
    const char* cA = (const char*)g.A + (size_t)cur.pm * tstepA + cur.aoff; const char* cB = (const char*)g.Bt + (size_t)cur.pn * tstepB;
    PG8_STAGE(PG8_SB(0, 0), cB, voffB); PG8_STAGE(PG8_SB(0, 1), cB + hstepB, voffB); PG8_STAGE(PG8_SA(0, 0), cA, voffA); PG8_STAGE(PG8_SA(0, 1), cA + hstepA, voffA);
    if (wr == 1) PG8_BAR;
    PG8_WAIT_V(2); PG8_BAR;
    PG8_STAGE(PG8_SB(1, 0), cB + kstep, voffB); PG8_STAGE(PG8_SA(1, 0), cA + kstep, voffA); PG8_STAGE(PG8_SB(1, 1), cB + hstepB + kstep, voffB);
    PG8_WAIT_V(6); PG8_BAR;
    for (;;) {
        const bool has_next = S.next(ui + 1, nxt);
        const char* nA = has_next ? (const char*)g.A + (size_t)nxt.pm * tstepA + nxt.aoff : cA; const char* nB = has_next ? (const char*)g.Bt + (size_t)nxt.pn * tstepB : cB;
        for (int t = 0; t < nt; t += 2) {
            const bool last = (t == nt - 2);
            const char* a1 = cA + (size_t)(t + 1) * kstep;
            const char* a2 = last ? nA : cA + (size_t)(t + 2) * kstep; const char* b2 = last ? nB : cB + (size_t)(t + 2) * kstep;
            const char* a3 = a2 + kstep; const char* b3 = b2 + kstep;
            PG8_LDB(B0, 0, 0); PG8_LDB(B1, 0, 1); PG8_SCHED; PG8_LDA(At, 0, 0); PG8_STAGE(PG8_SA(1, 1), a1 + hstepA, voffA);
            PG8_WAIT_V(8); PG8_WAIT_L(0); PG8_BAR; PG8_MMA(0, 0, At, B0); PG8_MMA(0, 1, At, B1); PG8_BAR; PG8_SCHED;
            PG8_LDA(At, 0, 1); PG8_STAGE(PG8_SB(0, 0), b2, voffB); PG8_STAGE(PG8_SB(0, 1), b2 + hstepB, voffB); PG8_STAGE(PG8_SA(0, 0), a2, voffA);
            PG8_WAIT_V(8); PG8_WAIT_L(0); PG8_BAR; PG8_MMA(1, 0, At, B0); PG8_MMA(1, 1, At, B1); PG8_BAR; PG8_SCHED;
            PG8_LDB(B0, 1, 0); PG8_LDB(B1, 1, 1); PG8_SCHED; PG8_LDA(At, 1, 0); PG8_STAGE(PG8_SA(0, 1), a2 + hstepA, voffA);
            PG8_WAIT_V(8); PG8_WAIT_L(0); PG8_BAR; PG8_MMA(0, 0, At, B0); PG8_MMA(0, 1, At, B1); PG8_BAR; PG8_SCHED;
            PG8_LDA(At, 1, 1); PG8_STAGE(PG8_SB(1, 0), b3, voffB); PG8_STAGE(PG8_SB(1, 1), b3 + hstepB, voffB); PG8_STAGE(PG8_SA(1, 0), a3, voffA);
            PG8_WAIT_V(8); PG8_WAIT_L(0); PG8_BAR; PG8_MMA(1, 0, At, B0); PG8_MMA(1, 1, At, B1); PG8_BAR; PG8_SCHED;
        }
        if (wr == 0) PG8_BAR;
        E(acc, cur, wr, wc, fr, fq);
        if (!has_next) break;
#pragma unroll
        for (int a = 0; a < 2; ++a)
#pragma unroll
            for (int b = 0; b < 2; ++b)
#pragma unroll
                for (int m = 0; m < 4; ++m)
#pragma unroll
                    for (int n = 0; n < 2; ++n) acc[a][b][m][n] = (f32x4){0.f, 0.f, 0.f, 0.f};
        cur = nxt; cA = nA; cB = nB; ++ui;
        if (wr == 1) PG8_BAR;
    }
    PG8_WAIT_V(0);
    PG8_BAR;
#undef PG8_SA
#undef PG8_SB
#undef PG8_STAGE
#undef PG8_LDA
#undef PG8_LDB
#undef PG8_MMA
#undef PG8_WAIT_V
#undef PG8_WAIT_L
#undef PG8_BAR
#undef PG8_SCHED
}
}
#define XB_TMO      128
#define XB_XCNT(j)  (256  + 64 * (j))
#define XB_XSUB(j)  (1280 + 64 * (j))
#define XB_XGEN(j)  (2304 + 64 * (j))
#define XB_TOP      3328
#define XB_TOPGEN   3392
#define XCD_BAR_WORDS 3456
#define XB_SPIN_CAP (1u << 18)
__device__ __forceinline__ unsigned xb_ld(unsigned* p)              { return __hip_atomic_load(p, __ATOMIC_RELAXED, __HIP_MEMORY_SCOPE_AGENT); }
__device__ __forceinline__ unsigned xb_add(unsigned* p, unsigned v) { return __hip_atomic_fetch_add(p, v, __ATOMIC_RELAXED, __HIP_MEMORY_SCOPE_AGENT); }
__device__ __forceinline__ unsigned xb_xcc_id() { return (unsigned)__builtin_amdgcn_s_getreg((3 << 11) | 20) & 0xFu; }
#define XB_SPIN(cond, bar) do { unsigned _sp = 0; while (cond) { __builtin_amdgcn_s_sleep(1); \
    if ((++_sp & 255u) == 0u) { if (xb_ld(&(bar)[XB_TMO])) break; if (_sp > XB_SPIN_CAP) { atomicAdd(&(bar)[XB_TMO], 1u); break; } } } } while (0)
struct XcdBarrier { unsigned* bar; unsigned x; volatile LAS unsigned* st; };
__device__ __forceinline__ XcdBarrier xcd_barrier_post(unsigned* bar, volatile LAS unsigned* st) {
    XcdBarrier b; b.bar = bar; b.x = xb_xcc_id(); b.st = st;
    if (threadIdx.x == 0) (void)xb_add(&bar[XB_XCNT(b.x)], 1u);
    return b;
}
__device__ __forceinline__ void xcd_barrier_complete(unsigned* bar, unsigned x, unsigned& nloc, unsigned& nx) {
    const unsigned G = gridDim.x * gridDim.y * gridDim.z;
    unsigned sum, cnt, mine, sp = 0u;
    for (;;) {
        sum = 0u; cnt = 0u; mine = 0u;
#pragma unroll
        for (unsigned j = 0; j < 16; ++j) { const unsigned c = xb_ld(&bar[XB_XCNT(j)]); sum += c; cnt += (c > 0u) ? 1u : 0u; mine = (j == x) ? c : mine; }
        if (sum == G) break;
        __builtin_amdgcn_s_sleep(1);
        if ((++sp & 255u) == 0u) { if (xb_ld(&bar[XB_TMO])) break; if (sp > XB_SPIN_CAP) { atomicAdd(&bar[XB_TMO], 1u); break; } }
    }
    nloc = mine > 0u ? mine : 1u; nx = cnt > 0u ? cnt : 1u;
}
__device__ __forceinline__ void xcd_barrier(const XcdBarrier& b) {
    asm volatile("s_waitcnt vmcnt(0)" ::: "memory");
    __syncthreads();
    if (threadIdx.x == 0) {
        unsigned* bar = b.bar;
        __builtin_amdgcn_s_waitcnt(0);
        unsigned nloc = b.st[0], nx = b.st[1];
        if (nloc == 0u) { xcd_barrier_complete(bar, b.x, nloc, nx); b.st[0] = nloc; b.st[1] = nx; }
        const unsigned old = xb_add(&bar[XB_XSUB(b.x)], 1u);
        const unsigned gen = old / nloc;
        if (old + 1u == (gen + 1u) * nloc) {
            __builtin_amdgcn_fence(__ATOMIC_RELEASE, "agent");
            asm volatile("s_waitcnt vmcnt(0)" ::: "memory");
            const unsigned og = xb_add(&bar[XB_TOP], 1u);
            const unsigned tg = og / nx;
            if (og + 1u == (tg + 1u) * nx) xb_add(&bar[XB_TOPGEN], 1u);
            else XB_SPIN(xb_ld(&bar[XB_TOPGEN]) == tg, bar);
            __builtin_amdgcn_fence(__ATOMIC_ACQUIRE, "agent");
            xb_add(&bar[XB_XGEN(b.x)], 1u);
            asm volatile("s_waitcnt vmcnt(0)" ::: "memory");
        } else {
            XB_SPIN(xb_ld(&bar[XB_XGEN(b.x)]) == gen, bar);
            __builtin_amdgcn_fence(__ATOMIC_ACQUIRE, "agent");
            asm volatile("s_waitcnt vmcnt(0)" ::: "memory");
        }
    }
    __syncthreads();
}

constexpr int RING_BYTES = 131072;
constexpr int MISC_OFF = RING_BYTES;
constexpr int LDS_BYTES = 147456;
constexpr int NWAVES = 8, NTHREADS = NWAVES * 64;

__device__ __forceinline__ void transpose_item(const float* W, int ldw, int K, float scale, bf16* WT, LAS float* scr, int k0, int lane) {
#pragma unroll 8
    for (int i = 0; i < 32; ++i) { const int kk = 2 * i + (lane >> 5); scr[kk * 33 + (lane & 31)] = W[(size_t)(k0 + kk) * ldw + (lane & 31)] * scale; }
    asm volatile("s_waitcnt vmcnt(0) lgkmcnt(0)" ::: "memory");
    const int c = lane & 7;
#pragma unroll
    for (int j = 0; j < 4; ++j) { const int n = (lane >> 3) + 8 * j; const LAS float* s = scr + (8 * c) * 33 + n;
        u32x4 o; o.x = pk2(s[0 * 33], s[1 * 33]); o.y = pk2(s[2 * 33], s[3 * 33]); o.z = pk2(s[4 * 33], s[5 * 33]); o.w = pk2(s[6 * 33], s[7 * 33]);
        *(u32x4*)(WT + (size_t)n * K + k0 + 8 * c) = o; }
    asm volatile("s_waitcnt lgkmcnt(0)" ::: "memory");
}
struct WPtrs { const float *w_in, *w_branch, *w_out, *w_gate, *w_up, *w_down; };
constexpr int IT_WIN = (NP / 32) * (D / 64), IT_WB = 3 * (D / 32) * (D / 64), IT_WO = (D / 32) * (D / 64), IT_WGU = (NGU / 32) * (D / 64), IT_WD = (D / 32) * (FF / 64);
constexpr int IT_LAYER = IT_WIN + IT_WB + IT_WO + IT_WGU + IT_WD, IT_ALL = DEPTH * IT_LAYER;
__device__ __forceinline__ void convert_item(const WPtrs& P, unsigned char* ws, int item, LAS float* scr, int lane) {
    const int l = item / IT_LAYER; int r = item % IT_LAYER;
    if (r < IT_WIN) { const int nb = r / (D / 64), kb = r % (D / 64); const int n0 = nb * 32; const int src = n0 < 6144 ? n0 : n0 + 16;
        const float sc = (n0 < 512 || (n0 >= C_GQ && n0 < C_GQ + 512)) ? 0.08838834764831845f : ((n0 >= C_SQ && n0 < C_SQ + 1024) ? 0.125f : 1.0f);
        transpose_item(P.w_in + (size_t)l * D * DIN_ORIG + src, DIN_ORIG, D, sc, (bf16*)(ws + WS_WIN) + ((size_t)l * NP + n0) * D, scr, kb * 64, lane); return; }
    r -= IT_WIN;
    if (r < IT_WB) { const int n = r / ((D / 32) * (D / 64)); const int q = r % ((D / 32) * (D / 64)); const int nb = q / (D / 64), kb = q % (D / 64);
        transpose_item(P.w_branch + ((size_t)(l * 3 + n) * D) * D + nb * 32, D, D, 1.0f, (bf16*)(ws + WS_WB) + ((size_t)(l * 3 + n) * D + nb * 32) * D, scr, kb * 64, lane); return; }
    r -= IT_WB;
    if (r < IT_WO) { const int nb = r / (D / 64), kb = r % (D / 64);
        transpose_item(P.w_out + (size_t)l * D * D + nb * 32, D, D, 1.0f, (bf16*)(ws + WS_WO) + ((size_t)l * D + nb * 32) * D, scr, kb * 64, lane); return; }
    r -= IT_WO;
    if (r < IT_WGU) { const int nb = r / (D / 64), kb = r % (D / 64); const int n0 = nb * 32; const int j = n0 / 256, i = n0 % 256;
        const float* src = (i < 128) ? (P.w_gate + (size_t)l * D * FF + 128 * j + i) : (P.w_up + (size_t)l * D * FF + 128 * j + (i - 128));
        transpose_item(src, FF, D, 1.0f, (bf16*)(ws + WS_WGU) + ((size_t)l * NGU + n0) * D, scr, kb * 64, lane); return; }
    r -= IT_WGU;
    { const int nb = r / (FF / 64), kb = r % (FF / 64);
        transpose_item(P.w_down + (size_t)l * FF * D + nb * 32, D, FF, 1.0f, (bf16*)(ws + WS_WD) + ((size_t)l * D + nb * 32) * FF, scr, kb * 64, lane); }
}

struct NormArgs { const float* xin; float* xout; const bf16* Y; const float* wpost; const float* wpre; bf16* Hout; float* GAout; int ldy; int pad; };
__device__ __forceinline__ void norm_row(const NormArgs& A, int row, int yrow, int lane, const LAS float* w1s) {
    const f32x4* xr = (const f32x4*)(A.xin + (size_t)row * D) + lane;
    f32x4 v[4];
#pragma unroll
    for (int j = 0; j < 4; ++j) v[j] = xr[64 * j];
    if (A.Y) {
        const u32x2* yr = (const u32x2*)(A.Y + (size_t)yrow * A.ldy) + lane; f32x4 y[4]; float ss = 0.f;
#pragma unroll
        for (int j = 0; j < 4; ++j) { const u32x2 w = yr[64 * j]; y[j] = (f32x4){bflo(w.x), bfhi(w.x), bflo(w.y), bfhi(w.y)}; ss += (y[j].x * y[j].x + y[j].y * y[j].y) + (y[j].z * y[j].z + y[j].w * y[j].w); }
        const float r = 1.0f / sqrtf(wave_sum(ss) * (1.0f / D) + NORM_EPS);
#pragma unroll
        for (int j = 0; j < 4; ++j) { const f32x4 w = ((const f32x4*)A.wpost)[lane + 64 * j]; v[j] = v[j] + y[j] * r * w; }
    }
    if (A.xout) { f32x4* xo = (f32x4*)(A.xout + (size_t)row * D) + lane;
#pragma unroll
        for (int j = 0; j < 4; ++j) xo[64 * j] = v[j]; }
    if (A.Hout) {
        float ss = 0.f;
#pragma unroll
        for (int j = 0; j < 4; ++j) ss += (v[j].x * v[j].x + v[j].y * v[j].y) + (v[j].z * v[j].z + v[j].w * v[j].w);
        const float r = 1.0f / sqrtf(wave_sum(ss) * (1.0f / D) + NORM_EPS);
        u32x2* ho = (u32x2*)(A.Hout + (size_t)row * D) + lane;
#pragma unroll
        for (int j = 0; j < 4; ++j) { const f32x4 w = ((const f32x4*)A.wpre)[lane + 64 * j]; v[j] = v[j] * r * w; u32x2 o; o.x = cvtpk(v[j].x, v[j].y); o.y = cvtpk(v[j].z, v[j].w); ho[64 * j] = o; }
        if (A.GAout) {
            float mine = 0.f;
#pragma unroll 1
            for (int c = 0; c < 16; ++c) { float p = 0.f;
#pragma unroll
                for (int j = 0; j < 4; ++j) { const f32x4 w = ((const LAS f32x4*)(w1s + c * D))[lane + 64 * j]; p += (v[j].x * w.x + v[j].y * w.y) + (v[j].z * w.z + v[j].w * w.w); }
                p = wave_sum(p); if (lane == c) mine = p; }
            if (lane < 16) A.GAout[(size_t)row * 16 + lane] = mine;
        }
    }
}
__device__ __forceinline__ void norm_phase(LAS unsigned char* lds, const NormArgs& A, const float* W1, int row0, int nrows, int vcu, int G) {
    LAS float* w1s = (LAS float*)lds;
    int tid_ = threadIdx.x; asm volatile("" : "+v"(tid_));
    if (A.GAout) { for (int i = tid_; i < 16 * D; i += NTHREADS) { const int k = i >> 4, c = i & 15; w1s[c * D + k] = W1[(size_t)k * DIN_ORIG + c]; } __syncthreads(); }
    const int wave = __builtin_amdgcn_readfirstlane(tid_ >> 6), lane = tid_ & 63;
    for (int r = vcu * NWAVES + wave; r < nrows; r += G * NWAVES) norm_row(A, row0 + r, r, lane, w1s);
    __syncthreads();
}

__device__ __forceinline__ void convert_phase(LAS unsigned char* lds, const WPtrs& wp, unsigned char* ws, int vcu, int G) {
    int tid_ = threadIdx.x; asm volatile("" : "+v"(tid_));
    const int wave = __builtin_amdgcn_readfirstlane(tid_ >> 6), lane = tid_ & 63;
    LAS float* scr = (LAS float*)(lds + wave * 8704);
    for (int it = vcu * NWAVES + wave; it < IT_ALL; it += G * NWAVES) convert_item(wp, ws, it, scr, lane);
    __syncthreads();
}
typedef short v4i16_t __attribute__((ext_vector_type(4)));
#define MFMA32(a, b, c) __builtin_amdgcn_mfma_f32_32x32x16_bf16((a), (b), (c), 0, 0, 0)
__device__ __forceinline__ bf16x8 tr_frag(const LAS unsigned char* p0, const LAS unsigned char* p1) {
    const v4i16_t a = __builtin_amdgcn_ds_read_tr16_b64_v4i16((LAS v4i16_t*)p0), b = __builtin_amdgcn_ds_read_tr16_b64_v4i16((LAS v4i16_t*)p1);
    return (bf16x8){a[0], a[1], a[2], a[3], b[0], b[1], b[2], b[3]};
}
__device__ __forceinline__ bf16x8 pack_acc8(const f32x16& x, int s) {
    u32x4 p; p.x = cvtpk(x[8 * s + 0], x[8 * s + 1]); p.y = cvtpk(x[8 * s + 2], x[8 * s + 3]); p.z = cvtpk(x[8 * s + 4], x[8 * s + 5]); p.w = cvtpk(x[8 * s + 6], x[8 * s + 7]);
    return __builtin_bit_cast(bf16x8, p);
}

__device__ __forceinline__ void gla_gate_phase(LAS unsigned char* lds, bf16* P, const float* GA  , const float* W2  , const float* balpha  , float* ebl, int vcu, int G) {
    int tid = threadIdx.x; asm volatile("" : "+v"(tid));
    LAS float* gas = (LAS float*)lds;
    LAS float* seg = (LAS float*)(lds + 4096);
    const int d = tid & 127, sg = tid >> 7;
    for (int unit = vcu; unit < (MH / CH) * 4; unit += G) {
        const int ck = unit >> 2, h = unit & 3; const size_t row0 = (size_t)ck * CH;
        if (tid < 256) *(LAS f32x4*)(gas + tid * 4) = *(const f32x4*)(GA + row0 * 16 + tid * 4);
        float w2r[16];
#pragma unroll
        for (int r = 0; r < 16; ++r) w2r[r] = W2[r * 512 + h * 128 + d];
        const float ba = balpha[h * 128 + d];
        __syncthreads();
        float bb[16]; float run = 0.f;
#pragma unroll
        for (int ii = 0; ii < 16; ++ii) { const int i = 16 * sg + ii; float z = ba;
#pragma unroll
            for (int r4 = 0; r4 < 4; ++r4) { const f32x4 g4 = *(const LAS f32x4*)(gas + i * 16 + 4 * r4); z += g4.x * w2r[4 * r4] + g4.y * w2r[4 * r4 + 1] + g4.z * w2r[4 * r4 + 2] + g4.w * w2r[4 * r4 + 3]; }
            const float ls = fminf(z, 0.f) - __logf(1.0f + __expf(-fabsf(z)));
            run += fmaxf(ls * (1.0f / 16.0f), -1.0f); bb[ii] = run; }
        seg[sg * 128 + d] = run;
        __syncthreads();
        float pre = 0.f;
#pragma unroll
        for (int s = 0; s < 3; ++s) if (s < sg) pre += seg[s * 128 + d];
        bf16* qp = P + (row0 + 16 * sg) * NP + C_GQ + h * 128 + d; bf16* kp = P + (row0 + 16 * sg) * NP + C_GK + h * 128 + d;
#pragma unroll
        for (int ii = 0; ii < 16; ++ii) { const float b = bb[ii] + pre; const float e = __expf(b), ei = __expf(-b);
            qp[(size_t)ii * NP] = (bf16)f2bf(bf2f(qp[(size_t)ii * NP]) * e); kp[(size_t)ii * NP] = (bf16)f2bf(bf2f(kp[(size_t)ii * NP]) * ei); }
        if (sg == 3) ebl[(size_t)ck * 512 + h * 128 + d] = __expf(bb[15] + pre);
        __syncthreads();
    }
}

constexpr int LA_QS = 0, LA_QSTR = 272, LA_KS = 17408, LA_VS = 34816, LA_VSTR = 528, LA_SC = 68608, LA_SCSTR = 144, LA_OST = 77824, LA_PART = 111616, LA_DEC = 115712, LA_END = 116224;
static_assert(LA_END <= RING_BYTES, "la lds");
__device__ __forceinline__ void la_unit(LAS unsigned char* lds, bf16* P, int bl, int h, bool gla, const float* ebl, const float* nw, const float* nb) {
    int tid = threadIdx.x; asm volatile("" : "+v"(tid));
    const int w = __builtin_amdgcn_readfirstlane(tid >> 6);
    const int cq = (gla ? C_GQ : C_RQ) + h * 128, ck = (gla ? C_GK : C_RK) + h * 128, cv = (gla ? C_GV : C_RV) + h * 256, cg = (gla ? C_GG : C_RG) + h * 256;
    char* Pc = (char*)(P + (size_t)bl * SEQ * NP);
    const float retdec = exp2f(64.0f * log2f(1.0f - exp2f(-5.0f - (float)h)));
#define LA_MAPS(t) const int qrow = (t) >> 4, qch = (t) & 15, vrow = (t) >> 5, vch = (t) & 31;   \
    const unsigned offQ = (unsigned)(qrow * NP + 8 * qch) * 2u, offV = (unsigned)(vrow * NP + 8 * vch) * 2u;
#define LA_G(rowu, colu, off) (Pc + ((size_t)(rowu) * NP + (colu)) * 2 + (off))
    f32x16 S[4];
#pragma unroll
    for (int dt = 0; dt < 4; ++dt)
#pragma unroll
        for (int i = 0; i < 16; ++i) S[dt][i] = 0.f;
    u32x4 qn[2], kn[2], vn[4];
    {
    LA_MAPS(tid)
#pragma unroll
    for (int k = 0; k < 2; ++k) { qn[k] = *(const u32x4*)LA_G(32 * k, cq, offQ); kn[k] = *(const u32x4*)LA_G(32 * k, ck, offQ); }
#pragma unroll
    for (int k = 0; k < 4; ++k) vn[k] = *(const u32x4*)LA_G(16 * k, cv, offV);
#pragma unroll
    for (int k = 0; k < 2; ++k) { *(LAS u32x4*)(lds + LA_QS + (qrow + 32 * k) * LA_QSTR + 16 * qch) = qn[k]; *(LAS u32x4*)(lds + LA_KS + (qrow + 32 * k) * LA_QSTR + 16 * qch) = kn[k]; }
#pragma unroll
    for (int k = 0; k < 4; ++k) *(LAS u32x4*)(lds + LA_VS + (vrow + 16 * k) * LA_VSTR + 16 * vch) = vn[k];
    if (tid < 128) *(LAS float*)(lds + LA_DEC + 4 * tid) = gla ? ebl[(size_t)(bl * NCH) * 512 + h * 128 + tid] : retdec;
    }
    __syncthreads();
    for (int n = 0; n < NCH; ++n) {
        const size_t row0 = (size_t)n * CH;
        int tl = tid; asm volatile("" : "+v"(tl));
        LA_MAPS(tl)
        int lane = tl & 63; asm volatile("" : "+v"(lane));
        const int r = lane & 31, h5 = lane >> 5;
        const int trq = (lane & 15) >> 2, trp = lane & 3, trb = (lane >> 4) & 1;
        const int trV = (8 * h5 + trq) * LA_VSTR + (32 * w + 16 * trb + 4 * trp) * 2;
        const int trK = (8 * h5 + trq) * LA_QSTR + (16 * trb + 4 * trp) * 2;
        if (n + 1 < NCH) {
#pragma unroll
            for (int k = 0; k < 2; ++k) { qn[k] = *(const u32x4*)LA_G(row0 + CH + 32 * k, cq, offQ); kn[k] = *(const u32x4*)LA_G(row0 + CH + 32 * k, ck, offQ); }
        }
        if (w < 3) {
            const int jt = w >> 1, it = (w + 1) >> 1;
            f32x16 t;
#pragma unroll
            for (int i = 0; i < 16; ++i) t[i] = 0.f;
#pragma unroll
            for (int s = 0; s < 8; ++s) {
                const bf16x8 a = *(const LAS bf16x8*)(lds + LA_KS + (32 * jt + r) * LA_QSTR + (16 * s + 8 * h5) * 2);
                const bf16x8 b = *(const LAS bf16x8*)(lds + LA_QS + (32 * it + r) * LA_QSTR + (16 * s + 8 * h5) * 2);
                t = MFMA32(a, b, t);
            }
            const int i = 32 * it + r;
#pragma unroll
            for (int g = 0; g < 4; ++g) { const int j0 = 32 * jt + 8 * g + 4 * h5; float v[4];
#pragma unroll
                for (int e = 0; e < 4; ++e) v[e] = (j0 + e <= i) ? t[4 * g + e] : 0.f;
                u32x2 o; o.x = cvtpk(v[0], v[1]); o.y = cvtpk(v[2], v[3]);
                *(LAS u32x2*)(lds + LA_SC + i * LA_SCSTR + j0 * 2) = o; }
        }
        __syncthreads();
        bf16x8 vf[4];
#pragma unroll
        for (int ks = 0; ks < 4; ++ks) vf[ks] = tr_frag(lds + LA_VS + trV + (16 * ks) * LA_VSTR, lds + LA_VS + trV + (16 * ks + 4) * LA_VSTR);
        __builtin_amdgcn_sched_barrier(0);
        f32x16 oa[2];
#pragma unroll
        for (int it = 0; it < 2; ++it) {
#pragma unroll
            for (int i = 0; i < 16; ++i) oa[it][i] = 0.f;
#pragma unroll
            for (int ks = 0; ks < 2 * it + 2; ++ks) {
                const bf16x8 b = *(const LAS bf16x8*)(lds + LA_SC + (32 * it + r) * LA_SCSTR + (16 * ks + 8 * h5) * 2);
                oa[it] = MFMA32(vf[ks], b, oa[it]);
            }
        }
#pragma unroll
        for (int dt = 0; dt < 4; ++dt)
#pragma unroll
            for (int s = 0; s < 2; ++s) {
                const bf16x8 a = pack_acc8(S[dt], s);
#pragma unroll
                for (int it = 0; it < 2; ++it) {
                    const LAS unsigned char* qb = lds + LA_QS + (32 * it + r) * LA_QSTR + (32 * dt + 16 * s + 4 * h5) * 2;
                    const u32x2 b0 = *(const LAS u32x2*)qb, b1 = *(const LAS u32x2*)(qb + 16);
                    const u32x4 bw = {b0.x, b0.y, b1.x, b1.y};
                    oa[it] = MFMA32(a, __builtin_bit_cast(bf16x8, bw), oa[it]);
                }
                __builtin_amdgcn_sched_barrier(0);
            }
#pragma unroll
        for (int dt = 0; dt < 4; ++dt) {
#pragma unroll
            for (int ks = 0; ks < 4; ++ks) {
                const bf16x8 a = tr_frag(lds + LA_KS + trK + (16 * ks) * LA_QSTR + 64 * dt, lds + LA_KS + trK + (16 * ks + 4) * LA_QSTR + 64 * dt);
                S[dt] = MFMA32(a, vf[ks], S[dt]);
            }
            __builtin_amdgcn_sched_barrier(0);
#pragma unroll
            for (int g = 0; g < 4; ++g) { const f32x4 dc = *(const LAS f32x4*)(lds + LA_DEC + (32 * dt + 8 * g + 4 * h5) * 4);
                S[dt][4 * g + 0] *= dc.x; S[dt][4 * g + 1] *= dc.y; S[dt][4 * g + 2] *= dc.z; S[dt][4 * g + 3] *= dc.w; }
            __builtin_amdgcn_sched_barrier(0);
        }
        if (n + 1 < NCH) {
#pragma unroll
            for (int k = 0; k < 4; ++k) vn[k] = *(const u32x4*)LA_G(row0 + CH + 16 * k, cv, offV);
        }
#pragma unroll
        for (int it = 0; it < 2; ++it) {
            float s1 = 0.f, s2 = 0.f;
#pragma unroll
            for (int i = 0; i < 16; ++i) { s1 += oa[it][i]; s2 += oa[it][i] * oa[it][i]; }
            s1 += __shfl_xor(s1, 32); s2 += __shfl_xor(s2, 32);
            if (h5 == 0) *(LAS f32x2*)(lds + LA_PART + (w * 64 + 32 * it + r) * 8) = (f32x2){s1, s2};
#pragma unroll
            for (int g = 0; g < 4; ++g) { u32x2 o; o.x = cvtpk(oa[it][4 * g], oa[it][4 * g + 1]); o.y = cvtpk(oa[it][4 * g + 2], oa[it][4 * g + 3]);
                *(LAS u32x2*)(lds + LA_OST + (32 * it + r) * LA_VSTR + (32 * w + 8 * g + 4 * h5) * 2) = o; }
        }
        __syncthreads();
        f32x4 nw0 = *(const f32x4*)(nw + h * 256 + 8 * vch), nw1 = *(const f32x4*)(nw + h * 256 + 8 * vch + 4), nb0 = {0.f, 0.f, 0.f, 0.f}, nb1 = {0.f, 0.f, 0.f, 0.f};
        if (!gla) { nb0 = *(const f32x4*)(nb + h * 256 + 8 * vch); nb1 = *(const f32x4*)(nb + h * 256 + 8 * vch + 4); }
        asm volatile("" : "+v"(nw0), "+v"(nw1), "+v"(nb0), "+v"(nb1));
#pragma unroll
        for (int k = 0; k < 4; ++k) {
            const int i = vrow + 16 * k;
            float s1 = 0.f, s2 = 0.f;
#pragma unroll
            for (int wv = 0; wv < 8; ++wv) { const f32x2 p = *(const LAS f32x2*)(lds + LA_PART + (wv * 64 + i) * 8); s1 += p.x; s2 += p.y; }
            const float mean = gla ? 0.f : s1 * (1.0f / 256.0f);
            const float var = s2 * (1.0f / 256.0f) - mean * mean;
            const float rstd = 1.0f / sqrtf(fmaxf(var, 0.f) + (gla ? NORM_EPS : GN_EPS));
            f32x4 o0, o1, g0, g1; { const u32x4 ow = *(const LAS u32x4*)(lds + LA_OST + i * LA_VSTR + 16 * vch); pg8::unpack8(ow, o0, o1); }
            { const u32x4 gw = *(const u32x4*)LA_G(row0 + 16 * k, cg, offV); pg8::unpack8(gw, g0, g1); }
            o0 = ((o0 - mean) * rstd * nw0 + nb0) * g0; o1 = ((o1 - mean) * rstd * nw1 + nb1) * g1;
            *(u32x4*)LA_G(row0 + 16 * k, cv, offV) = pg8::pack8(o0, o1);
        }
        if (n + 1 < NCH) {
#pragma unroll
            for (int k = 0; k < 2; ++k) { *(LAS u32x4*)(lds + LA_QS + (qrow + 32 * k) * LA_QSTR + 16 * qch) = qn[k]; *(LAS u32x4*)(lds + LA_KS + (qrow + 32 * k) * LA_QSTR + 16 * qch) = kn[k]; }
#pragma unroll
            for (int k = 0; k < 4; ++k) *(LAS u32x4*)(lds + LA_VS + (vrow + 16 * k) * LA_VSTR + 16 * vch) = vn[k];
            if (gla && tl < 128) *(LAS float*)(lds + LA_DEC + 4 * tl) = ebl[(size_t)(bl * NCH + n + 1) * 512 + h * 128 + tl];
        }
        __syncthreads();
    }
#undef LA_G
#undef LA_MAPS
}
constexpr int SW_KS = 0, SW_STR = 144, SW_VS = 36864, SW_END = 73728;
__device__ __forceinline__ void swa_unit(LAS unsigned char* lds, bf16* P, int bl, int n, int kvh, const float* sinks) {
    int tid = threadIdx.x; asm volatile("" : "+v"(tid));
    const int w = __builtin_amdgcn_readfirstlane(tid >> 6), lane = tid & 63, r = lane & 31, h5 = lane >> 5;
    const int g = w >> 1, qh = w & 1, hq = 4 * kvh + g;
    bf16* Pb = P + ((size_t)bl * SEQ + (size_t)n * 128) * NP;
    {
        const int ch = tid & 7;
#pragma unroll
        for (int k = 0; k < 4; ++k) { const int j = (tid >> 3) + 64 * k;
            if (n > 0 || j >= 128) { const bf16* src = Pb + (ptrdiff_t)(j - 128) * NP + kvh * 64 + 8 * ch;
                const u32x4 kk = *(const u32x4*)(src + C_SK), vv = *(const u32x4*)(src + C_SV);
                *(LAS u32x4*)(lds + SW_KS + j * SW_STR + 16 * ch) = kk; *(LAS u32x4*)(lds + SW_VS + j * SW_STR + 16 * ch) = vv; } }
    }
    bf16x8 qf[2][4];
#pragma unroll
    for (int q2 = 0; q2 < 2; ++q2)
#pragma unroll
        for (int s = 0; s < 4; ++s) qf[q2][s] = *(const bf16x8*)(Pb + (size_t)(64 * qh + 32 * q2 + r) * NP + C_SQ + hq * 64 + 16 * s + 8 * h5);
    const float slope = exp2f(-0.5f * (float)(hq + 1)), sink = sinks[hq];
    const int trq = (lane & 15) >> 2, trp = lane & 3, trb = (lane >> 4) & 1;
    const int trV = (4 * h5 + trq) * SW_STR + (16 * trb + 4 * trp) * 2;
    __syncthreads();
#pragma unroll
    for (int q2 = 0; q2 < 2; ++q2) {
        const int qi = 2 * qh + q2;
        f32x16 sc[5];
        float mx = -__builtin_inff();
#pragma unroll
        for (int kt = 0; kt < 5; ++kt) {
            const int kj = qi + kt; const bool ok = (n > 0) || (kj >= 4);
#pragma unroll
            for (int i = 0; i < 16; ++i) sc[kt][i] = 0.f;
            if (ok) {
#pragma unroll
                for (int s = 0; s < 4; ++s) { const bf16x8 a = *(const LAS bf16x8*)(lds + SW_KS + (32 * kj + r) * SW_STR + (16 * s + 8 * h5) * 2); sc[kt] = MFMA32(a, qf[q2][s], sc[kt]); }
            }
#pragma unroll
            for (int rr = 0; rr < 16; ++rr) { const int dist = 128 + (32 * qi + r) - (32 * kj + (rr & 3) + 8 * (rr >> 2) + 4 * h5);
                bool valid = ok; if (kt == 0) valid = valid && (dist <= 127); if (kt == 4) valid = valid && (dist >= 0);
                const float l = valid ? (sc[kt][rr] - slope * (float)dist) : -__builtin_inff();
                sc[kt][rr] = l; mx = fmaxf(mx, l); }
        }
        mx = fmaxf(mx, __shfl_xor(mx, 32)); mx = fmaxf(mx, sink);
        float sum = 0.f;
#pragma unroll
        for (int kt = 0; kt < 5; ++kt)
#pragma unroll
            for (int rr = 0; rr < 16; ++rr) { const float p = __expf(sc[kt][rr] - mx); sc[kt][rr] = p; sum += p; }
        sum += __shfl_xor(sum, 32);
        const float inv = 1.0f / (sum + __expf(sink - mx));
        f32x16 oa[2];
#pragma unroll
        for (int dt = 0; dt < 2; ++dt)
#pragma unroll
            for (int i = 0; i < 16; ++i) oa[dt][i] = 0.f;
#pragma unroll
        for (int kt = 0; kt < 5; ++kt) {
            const int kj = qi + kt; const bool ok = (n > 0) || (kj >= 4);
            if (ok) {
#pragma unroll
                for (int s = 0; s < 2; ++s) { const bf16x8 b = pack_acc8(sc[kt], s);
#pragma unroll
                    for (int dt = 0; dt < 2; ++dt) { const LAS unsigned char* vb = lds + SW_VS + trV + (32 * kj + 16 * s) * SW_STR + 64 * dt;
                        const bf16x8 a = tr_frag(vb, vb + 8 * SW_STR); oa[dt] = MFMA32(a, b, oa[dt]); } }
            }
        }
        bf16* op = Pb + (size_t)(64 * qh + 32 * q2 + r) * NP + C_SQ + hq * 64;
#pragma unroll
        for (int dt = 0; dt < 2; ++dt)
#pragma unroll
            for (int gg = 0; gg < 4; ++gg) { u32x2 o; o.x = cvtpk(oa[dt][4 * gg] * inv, oa[dt][4 * gg + 1] * inv); o.y = cvtpk(oa[dt][4 * gg + 2] * inv, oa[dt][4 * gg + 3] * inv);
                *(u32x2*)(op + 32 * dt + 8 * gg + 4 * h5) = o; }
    }
    __syncthreads();
}

struct MixArgs { bf16* P; const float* ebl; const float *ret_w, *ret_b, *gla_w, *sinks; int do_la, do_swa; };
__device__ __forceinline__ void mix_phase(LAS unsigned char* lds, const MixArgs& A, int bx, int G) {
    asm volatile("" : "+s"(bx));
    constexpr int NLA = BH * 4 * 2, NSW = BH * 16 * 4;
    if (bx < NLA) { const bool gla = bx >= BH * 4; const int u = bx % (BH * 4);
        if (A.do_la) la_unit(lds, A.P, u >> 2, u & 3, gla, A.ebl, gla ? A.gla_w : A.ret_w, A.ret_b); }
    else if (A.do_swa) { for (int u = bx - NLA; u < NSW; u += G - NLA) swa_unit(lds, A.P, u >> 6, (u >> 2) & 15, u & 3, A.sinks); }
}
template <bool GLA>
__global__ __launch_bounds__(256) void k_mix_rec(bf16* P, const float* GA  , const float* W2  , const float* balpha  ) {
    __shared__ __attribute__((aligned(16))) float sq[2][128], sk[2][128], sa[2][128];
    const int bl = blockIdx.x >> 2, h = blockIdx.x & 3, e = threadIdx.x;
    const int cq = (GLA ? C_GQ : C_RQ) + h * 128, ck = (GLA ? C_GK : C_RK) + h * 128, cv = (GLA ? C_GV : C_RV) + h * 256;
    float S[128];
#pragma unroll
    for (int d = 0; d < 128; ++d) S[d] = 0.f;
    const float gam = 1.0f - exp2f(-5.0f - (float)h);
    float w2r[16]; float ba = 0.f;
    if (GLA && e < 128) {
#pragma unroll
        for (int r = 0; r < 16; ++r) w2r[r] = W2[r * 512 + h * 128 + e];
        ba = balpha[h * 128 + e];
    }
    for (int t = 0; t < SEQ; ++t) {
        const size_t row = (size_t)bl * SEQ + t; const int pb = t & 1;
        if (e < 128) {
            sq[pb][e] = bf2f(P[row * NP + cq + e]); sk[pb][e] = bf2f(P[row * NP + ck + e]);
            float a = gam;
            if (GLA) { float z = ba;
#pragma unroll
                for (int r = 0; r < 16; ++r) z += GA[row * 16 + r] * w2r[r];
                const float ls = fminf(z, 0.f) - log1pf(__expf(-fabsf(z)));
                a = __expf(fmaxf(ls * (1.0f / 16.0f), -1.0f)); }
            sa[pb][e] = a;
        }
        const float v = bf2f(P[row * NP + cv + e]);
        __syncthreads();
        float o = 0.f;
#pragma unroll
        for (int d4 = 0; d4 < 32; ++d4) {
            const f32x4 q4 = *(const f32x4*)&sq[pb][4 * d4], k4 = *(const f32x4*)&sk[pb][4 * d4], a4 = *(const f32x4*)&sa[pb][4 * d4];
            S[4 * d4 + 0] = a4.x * S[4 * d4 + 0] + k4.x * v; o += q4.x * S[4 * d4 + 0];
            S[4 * d4 + 1] = a4.y * S[4 * d4 + 1] + k4.y * v; o += q4.y * S[4 * d4 + 1];
            S[4 * d4 + 2] = a4.z * S[4 * d4 + 2] + k4.z * v; o += q4.z * S[4 * d4 + 2];
            S[4 * d4 + 3] = a4.w * S[4 * d4 + 3] + k4.w * v; o += q4.w * S[4 * d4 + 3];
        }
        P[row * NP + cv + e] = (bf16)f2bf(o);
    }
}
__global__ __launch_bounds__(256) void k_norm_gate(bf16* P, const float* rw, const float* rb, const float* gw) {
    const int wave = threadIdx.x >> 6, lane = threadIdx.x & 63;
    for (int it = blockIdx.x * 4 + wave; it < MH * 8; it += gridDim.x * 4) {
        const int row = it >> 3, which = (it >> 2) & 1, h = it & 3;
        const int cv = (which ? C_GV : C_RV) + h * 256, cg = (which ? C_GG : C_RG) + h * 256;
        u32x2* op = (u32x2*)(P + (size_t)row * NP + cv) + lane; const u32x2 ow = *op; const u32x2 gw2 = *((const u32x2*)(P + (size_t)row * NP + cg) + lane);
        f32x4 o = {bflo(ow.x), bfhi(ow.x), bflo(ow.y), bfhi(ow.y)}; const f32x4 g = {bflo(gw2.x), bfhi(gw2.x), bflo(gw2.y), bfhi(gw2.y)};
        f32x4 y;
        if (!which) { const float mu = wave_sum((o.x + o.y) + (o.z + o.w)) * (1.0f / 256.0f); o = o - mu; const float var = wave_sum((o.x * o.x + o.y * o.y) + (o.z * o.z + o.w * o.w)) * (1.0f / 256.0f);
            const float r = 1.0f / sqrtf(var + GN_EPS); const f32x4 w = ((const f32x4*)(rw + h * 256))[lane], b = ((const f32x4*)(rb + h * 256))[lane]; y = (o * r * w + b) * g; }
        else { const float ms = wave_sum((o.x * o.x + o.y * o.y) + (o.z * o.z + o.w * o.w)) * (1.0f / 256.0f); const float r = 1.0f / sqrtf(ms + NORM_EPS); const f32x4 w = ((const f32x4*)(gw + h * 256))[lane]; y = o * r * w * g; }
        u32x2 out; out.x = pk2(y.x, y.y); out.y = pk2(y.z, y.w); *op = out;
    }
}
__global__ __launch_bounds__(256) void k_swa_naive(bf16* P, const float* sinks) {
    __shared__ float sqv[4][64];
    const int wave = threadIdx.x >> 6, lane = threadIdx.x & 63;
    for (int it = blockIdx.x * 4 + wave; it < MH * 16; it += gridDim.x * 4) {
        const int row = it >> 4, h = it & 15, kvh = h >> 2, t = row % SEQ;
        const float slope = exp2f(-8.0f * (float)(h + 1) / 16.0f), sink = sinks[h];
        sqv[wave][lane] = bf2f(P[(size_t)row * NP + C_SQ + h * 64 + lane]);
        __builtin_amdgcn_s_waitcnt(0); __builtin_amdgcn_wave_barrier();
        float lg[2];
#pragma unroll
        for (int u = 0; u < 2; ++u) { const int dist = lane + 64 * u; float s = -__builtin_inff();
            if (dist <= t) { const bf16* kr = P + (size_t)(row - dist) * NP + C_SK + kvh * 64; s = 0.f;
                for (int d = 0; d < 64; ++d) s += sqv[wave][d] * bf2f(kr[d]);
                s -= slope * (float)dist; }
            lg[u] = s; }
        const float m = fmaxf(wave_max(fmaxf(lg[0], lg[1])), sink);
        const float p0 = __expf(lg[0] - m), p1 = __expf(lg[1] - m);
        const float den = wave_sum(p0 + p1) + __expf(sink - m);
        float o = 0.f;
        for (int dist = 0; dist < 128; ++dist) { const float p = __shfl(dist < 64 ? p0 : p1, dist & 63); if (dist <= t) o += p * bf2f(P[(size_t)(row - dist) * NP + C_SV + kvh * 64 + lane]); }
        __builtin_amdgcn_wave_barrier();
        P[(size_t)row * NP + C_SQ + h * 64 + lane] = (bf16)f2bf(o / den);
    }
}

struct Args {
    const float *x, *norm_mix_pre, *norm_mix_post, *w_in, *ret_norm_w, *ret_norm_b, *gla_w_alpha2, *gla_b_alpha, *gla_norm_w, *attn_sinks, *w_branch, *w_out, *norm_ffn_pre, *norm_ffn_post, *ffn_w_gate, *ffn_w_up, *ffn_w_down;
    float* out; unsigned char* ws; int ph_lo, ph_hi, ret_scale, bar_region, do_la, do_swa;
};
constexpr int PH_PER_HALF = 6, PH_PER_LAYER = NSPLIT * PH_PER_HALF + 3, PH_TOTAL = 1 + DEPTH * PH_PER_LAYER;
__global__ void __launch_bounds__(NTHREADS, 2) mega(Args a) {
    extern __shared__ __attribute__((aligned(16))) unsigned char lds_raw[];
    LAS unsigned char* lds = (LAS unsigned char*)lds_raw;
    volatile LAS unsigned* MISC = (volatile LAS unsigned*)(lds + MISC_OFF);
    const int G = gridDim.x; const int bx = blockIdx.x; const int vcu = (G % 8 == 0) ? (bx % 8) * (G / 8) + bx / 8 : bx;
    for (int u = threadIdx.x; u < (LDS_BYTES - MISC_OFF) / 4; u += NTHREADS) ((LAS unsigned*)(lds + MISC_OFF))[u] = 0u;
    __syncthreads();
    unsigned char* ws = a.ws;
    XcdBarrier bar = xcd_barrier_post((unsigned*)(ws + WS_CTL) + a.bar_region * XCD_BAR_WORDS, MISC + 8);
    bf16* WinT = (bf16*)(ws + WS_WIN); bf16* WbT = (bf16*)(ws + WS_WB); bf16* WoT = (bf16*)(ws + WS_WO); bf16* WguT = (bf16*)(ws + WS_WGU); bf16* WdT = (bf16*)(ws + WS_WD);
    float* GA = (float*)(ws + WS_GA); bf16* H = (bf16*)(ws + WS_H); bf16* PROJ = (bf16*)(ws + WS_PROJ); bf16* U = (bf16*)(ws + WS_U); bf16* F = (bf16*)(ws + WS_F);
    const int lo = a.ph_lo, hi = a.ph_hi;
    int p = 0;
#define RUN() (lo <= p && p < hi)
#define SEAM() do { if (lo <= p && p + 1 < hi) xcd_barrier(bar); ++p; } while (0)

    if (RUN()) {
        { WPtrs wp{a.w_in, a.w_branch, a.w_out, a.ffn_w_gate, a.ffn_w_up, a.ffn_w_down};
          convert_phase(lds, wp, ws, vcu, G); }
        { NormArgs na{a.x, nullptr, nullptr, nullptr, a.norm_mix_pre, H, GA, 0, 0}; norm_phase(lds, na, a.w_in + GA_ORIG, 0, M, vcu, G); }
    }
    SEAM();
    for (int l = 0; l < DEPTH; ++l) {
        const float* xin = l == 0 ? a.x : a.out;
        for (int hf = 0; hf < NSPLIT; ++hf) {
            const int r0 = hf * MH;
            if (RUN()) { pg8::Gemm g{H + (size_t)r0 * D, WinT + (size_t)l * NP * D, D, D, D}; pg8::StaticOrder S; S.init(MH, NP, G, bx); pg8::EpiInProj E{PROJ, a.ret_scale, 0};
                pg8::gemm_phase<pg8::EpiInProj, pg8::StaticOrder>(lds, g, S, E); }
            SEAM();
            if (RUN()) { if (a.do_la) gla_gate_phase(lds, PROJ, GA + (size_t)r0 * 16, a.gla_w_alpha2 + (size_t)l * 16 * 512, a.gla_b_alpha + (size_t)l * 512, (float*)(ws + WS_EBL), vcu, G); }
            SEAM();
            if (RUN()) { MixArgs ma{PROJ, (const float*)(ws + WS_EBL), a.ret_norm_w + l * 1024, a.ret_norm_b + l * 1024, a.gla_norm_w + l * 1024, a.attn_sinks + l * 16, a.do_la, a.do_swa}; mix_phase(lds, ma, bx, G); }
            SEAM();
            if (RUN()) { pg8::Gemm g{PROJ, WbT + (size_t)l * 3 * D * D, NP, D, D}; pg8::MergeOrder S; S.init(MH, G, bx); pg8::EpiMerge E{PROJ};
                pg8::gemm_phase<pg8::EpiMerge, pg8::MergeOrder>(lds, g, S, E); }
            SEAM();
            if (RUN()) { pg8::Gemm g{PROJ + C_MERGED, WoT + (size_t)l * D * D, NP, D, D}; pg8::StaticOrder S; S.init(MH, D, G, bx); pg8::EpiPlain E{PROJ + C_Y, NP, 0};
                pg8::gemm_phase<pg8::EpiPlain, pg8::StaticOrder>(lds, g, S, E); }
            SEAM();
            if (RUN()) { NormArgs na{xin, a.out, PROJ + C_Y, a.norm_mix_post + l * D, a.norm_ffn_pre + l * D, H, nullptr, NP, 0}; norm_phase(lds, na, nullptr, r0, MH, vcu, G); }
            SEAM();
        }
        if (RUN()) { pg8::Gemm g{H, WguT + (size_t)l * NGU * D, D, D, D}; pg8::StaticOrder S; S.init(M, NGU, G, bx); pg8::EpiSwiglu E{U};
            pg8::gemm_phase<pg8::EpiSwiglu, pg8::StaticOrder>(lds, g, S, E); }
        SEAM();
        if (RUN()) { pg8::Gemm g{U, WdT + (size_t)l * D * FF, FF, FF, FF}; pg8::StaticOrder S; S.init(M, D, G, bx); pg8::EpiPlain E{F, D, 0};
            pg8::gemm_phase<pg8::EpiPlain, pg8::StaticOrder>(lds, g, S, E); }
        SEAM();
        if (RUN()) {
            if (l + 1 < DEPTH) { NormArgs na{a.out, a.out, F, a.norm_ffn_post + l * D, a.norm_mix_pre + (l + 1) * D, H, GA, D, 0}; norm_phase(lds, na, a.w_in + (size_t)(l + 1) * D * DIN_ORIG + GA_ORIG, 0, M, vcu, G); }
            else { NormArgs na{a.out, a.out, F, a.norm_ffn_post + l * D, nullptr, nullptr, nullptr, D, 0}; norm_phase(lds, na, nullptr, 0, M, vcu, G); }
        }
        SEAM();
    }
#undef RUN
#undef SEAM
}
#ifndef OPT_LA
#define OPT_LA 1
#endif
#ifndef OPT_SWA
#define OPT_SWA 1
#endif
#ifndef SINGLE_LAUNCH
#define SINGLE_LAUNCH 0
#endif
extern "C" void kernel_launch(void* const* d_in, const int* in_sizes, int n_in, void* d_out, int out_size, void* d_ws, size_t ws_size, hipStream_t stream) {
    static int grid = 0;
    if (grid == 0) {
        if (ws_size < WS_END || n_in != 17 || out_size != M * D) { fprintf(stderr, "kernel_launch: unexpected sizes (ws %zu, need %zu)\n", ws_size, (size_t)WS_END); grid = -1; return; }
        int dev = 0, cus = 0, per_cu = 0;
        if (hipGetDevice(&dev) != hipSuccess || hipDeviceGetAttribute(&cus, hipDeviceAttributeMultiprocessorCount, dev) != hipSuccess) { grid = -1; return; }
        if (hipFuncSetAttribute((const void*)mega, hipFuncAttributeMaxDynamicSharedMemorySize, LDS_BYTES) != hipSuccess) { fprintf(stderr, "kernel_launch: hipFuncSetAttribute failed\n"); grid = -1; return; }
        if (hipOccupancyMaxActiveBlocksPerMultiprocessor(&per_cu, (const void*)mega, NTHREADS, LDS_BYTES) != hipSuccess || per_cu < 1) { fprintf(stderr, "kernel_launch: occupancy query says %d\n", per_cu); }
        (void)hipGetLastError();
        grid = cus;
    }
    if (grid < 0) return;
    (void)hipMemsetAsync((char*)d_ws + WS_CTL, 0, CTL_ZERO_BYTES, stream);
    Args a{};
    a.x = (const float*)d_in[0]; a.norm_mix_pre = (const float*)d_in[1]; a.norm_mix_post = (const float*)d_in[2]; a.w_in = (const float*)d_in[3];
    a.ret_norm_w = (const float*)d_in[4]; a.ret_norm_b = (const float*)d_in[5]; a.gla_w_alpha2 = (const float*)d_in[6]; a.gla_b_alpha = (const float*)d_in[7];
    a.gla_norm_w = (const float*)d_in[8]; a.attn_sinks = (const float*)d_in[9]; a.w_branch = (const float*)d_in[10]; a.w_out = (const float*)d_in[11];
    a.norm_ffn_pre = (const float*)d_in[12]; a.norm_ffn_post = (const float*)d_in[13]; a.ffn_w_gate = (const float*)d_in[14]; a.ffn_w_up = (const float*)d_in[15]; a.ffn_w_down = (const float*)d_in[16];
    a.out = (float*)d_out; a.ws = (unsigned char*)d_ws; a.ret_scale = OPT_LA; a.bar_region = 0; a.do_la = OPT_LA; a.do_swa = OPT_SWA;
    unsigned char* ws = (unsigned char*)d_ws; bf16* PROJ = (bf16*)(ws + WS_PROJ); float* GA = (float*)(ws + WS_GA);
    int nlaunch = 0;
    auto run = [&](int lo, int hi) { a.ph_lo = lo; a.ph_hi = hi; a.bar_region = (hi - lo > 1) ? nlaunch++ : 17;   hipLaunchKernelGGL(mega, dim3(grid), dim3(NTHREADS), LDS_BYTES, stream, a); };
#if SINGLE_LAUNCH
    run(0, PH_TOTAL);
#else
    run(0, 1);
    for (int l = 0; l < DEPTH; ++l) {
        for (int hf = 0; hf < NSPLIT; ++hf) {
            const int pb = 1 + l * PH_PER_LAYER + hf * PH_PER_HALF; const int r0 = hf * MH;
            run(pb, pb + 1);
            run(pb + 1, pb + 2);
            run(pb + 2, pb + 3);
#if !OPT_LA
            k_mix_rec<false><<<BH * 4, 256, 0, stream>>>(PROJ, nullptr, nullptr, nullptr);
            k_mix_rec<true><<<BH * 4, 256, 0, stream>>>(PROJ, GA + (size_t)r0 * 16, a.gla_w_alpha2 + (size_t)l * 16 * 512, a.gla_b_alpha + (size_t)l * 512);
            k_norm_gate<<<2048, 256, 0, stream>>>(PROJ, a.ret_norm_w + l * 1024, a.ret_norm_b + l * 1024, a.gla_norm_w + l * 1024);
#endif
#if !OPT_SWA
            k_swa_naive<<<2048, 256, 0, stream>>>(PROJ, a.attn_sinks + l * 16);
#endif
            run(pb + 3, pb + 6);
        }
        const int pf = 1 + l * PH_PER_LAYER + NSPLIT * PH_PER_HALF;
        run(pf, pf + 3);
    }
#endif
}
```
